# Optimizing an MI355X kernel written in HIP

```python
import math
import jax, jax.numpy as jnp
from jax import lax
import numpy as np

D_MODEL = 2048
BATCH = 4
SEQ = 4096
DEPTH = 1

CTX_LEN = 256
GRID_W = 64
EPS = 1e-6
N_MOD = 6
S5_WIDTH = 1024
S5_GROUP = 16
S5_GROUPS = S5_WIDTH // S5_GROUP
S5_STATE = 64
POOL_WIDTH = 1024
POOL_WINDOWS = (2, 4, 8, 16)
POOL_GROUPS = len(POOL_WINDOWS)
POOL_GROUP_W = POOL_WIDTH // POOL_GROUPS
N_BRANCH = 2
IN_WIDTH = S5_WIDTH + POOL_WIDTH + N_BRANCH * D_MODEL
PEER_HEADS = 8
PEER_KEYS = 128
PEER_EXPERTS = PEER_KEYS * PEER_KEYS
PEER_QDIM = 256
PEER_HALF = PEER_QDIM // 2
PEER_TOPK = 16
PEER_BLOCK = 128

kernel_name = "hybrid_s5_pool_peer_dit_block"


def rmsnorm(x, w):
    xf = x.astype(jnp.float32)
    y = xf * lax.rsqrt(jnp.mean(xf * xf, axis=-1, keepdims=True) + EPS)
    return (y * w.astype(jnp.float32)).astype(x.dtype)


def modulate(x, w, shift, scale):
    return rmsnorm(x, w) * (1 + scale) + shift


def s5_discretise(a_re, a_im, log_dt, b_re, b_im):
    a_re = a_re.astype(jnp.float32)
    a_im = a_im.astype(jnp.float32)
    b_re = b_re.astype(jnp.float32)
    b_im = b_im.astype(jnp.float32)
    dt = jnp.exp(log_dt.astype(jnp.float32))[:, None]
    mag = jnp.exp(dt * a_re)
    ab_re = mag * jnp.cos(dt * a_im)
    ab_im = mag * jnp.sin(dt * a_im)
    den = a_re * a_re + a_im * a_im
    nr = ab_re - 1.0
    ni = ab_im
    f_re = (nr * a_re + ni * a_im) / den
    f_im = (ni * a_re - nr * a_im) / den
    bb_re = f_re[..., None] * b_re - f_im[..., None] * b_im
    bb_im = f_re[..., None] * b_im + f_im[..., None] * b_re
    return ab_re, ab_im, bb_re, bb_im


def _complex_affine_combine(e1, e2):
    a1r, a1i, b1r, b1i = e1
    a2r, a2i, b2r, b2i = e2
    return (a2r * a1r - a2i * a1i,
            a2r * a1i + a2i * a1r,
            a2r * b1r - a2i * b1i + b2r,
            a2r * b1i + a2i * b1r + b2i)


def s5_scan(u, ab_re, ab_im, bb_re, bb_im, reverse, h0_re=None, h0_im=None):
    L = u.shape[1]
    b_re = jnp.einsum('blgh,gph->blgp', u, bb_re)
    b_im = jnp.einsum('blgh,gph->blgp', u, bb_im)
    a_re = jnp.broadcast_to(ab_re[None, None], (1, L) + ab_re.shape)
    a_im = jnp.broadcast_to(ab_im[None, None], (1, L) + ab_im.shape)
    p_re, p_im, h_re, h_im = lax.associative_scan(
        _complex_affine_combine, (a_re, a_im, b_re, b_im), reverse=reverse, axis=1)
    if h0_re is not None:
        h0_re = h0_re[:, None]
        h0_im = h0_im[:, None]
        h_re, h_im = (h_re + p_re * h0_re - p_im * h0_im,
                      h_im + p_re * h0_im + p_im * h0_re)
    return h_re, h_im


def s5_readout(h_re, h_im, c_re, c_im):
    return (jnp.einsum('blgp,ghp->blgh', h_re, c_re.astype(jnp.float32))
            - jnp.einsum('blgp,ghp->blgh', h_im, c_im.astype(jnp.float32)))


def s5_output(y, u, d_skip, w_glu, b_glu, dtype):
    Bn, L = u.shape[:2]
    y = y.reshape(Bn, L, S5_WIDTH) + d_skip.astype(jnp.float32) * u.reshape(Bn, L, S5_WIDTH)
    g = jax.nn.gelu(y)
    return (g * jax.nn.sigmoid(g @ w_glu.astype(jnp.float32) + b_glu.astype(jnp.float32))).astype(dtype)


def s5_branch(u_lat, u_ctx, a_re, a_im, log_dt, b_re, b_im, c_re, c_im, d_skip, w_glu, b_glu, need_ctx):
    Bn, L, _ = u_lat.shape
    Lc = u_ctx.shape[1]
    ul = u_lat.astype(jnp.float32).reshape(Bn, L, S5_GROUPS, S5_GROUP)
    uc = u_ctx.astype(jnp.float32).reshape(Bn, Lc, S5_GROUPS, S5_GROUP)
    y_lat = 0.0
    y_ctx = 0.0
    for d, rev in enumerate((False, True)):
        ab_re, ab_im, bb_re, bb_im = s5_discretise(a_re[d], a_im[d], log_dt[d], b_re[d], b_im[d])
        hc_re, hc_im = s5_scan(uc, ab_re, ab_im, bb_re, bb_im, rev)
        end = 0 if rev else Lc - 1
        hl_re, hl_im = s5_scan(ul, ab_re, ab_im, bb_re, bb_im, rev, hc_re[:, end], hc_im[:, end])
        y_lat = y_lat + s5_readout(hl_re, hl_im, c_re[d], c_im[d])
        if need_ctx:
            y_ctx = y_ctx + s5_readout(hc_re, hc_im, c_re[d], c_im[d])
    out_lat = s5_output(y_lat, ul, d_skip, w_glu, b_glu, u_lat.dtype)
    out_ctx = s5_output(y_ctx, uc, d_skip, w_glu, b_glu, u_ctx.dtype) if need_ctx else None
    return out_lat, out_ctx


def pool_branch(u, n_seg, seg_len, pool_w, pool_scale):
    Bn, L, _ = u.shape
    us = u.astype(jnp.float32).reshape(Bn, n_seg, seg_len, POOL_GROUPS, POOL_GROUP_W)
    cs = jnp.pad(jnp.cumsum(us, axis=2), ((0, 0), (0, 0), (1, 0), (0, 0), (0, 0)))
    pos = jnp.arange(seg_len)
    outs = []
    for g, w in enumerate(POOL_WINDOWS):
        lo = jnp.clip(pos - w // 2, 0, seg_len - 1)
        hi = jnp.clip(pos + w // 2 - 1, 0, seg_len - 1)
        cs_g = cs[:, :, :, g]
        win_sum = jnp.take(cs_g, hi + 1, axis=2) - jnp.take(cs_g, lo, axis=2)
        cnt = (hi - lo + 1).astype(jnp.float32)[:, None]
        outs.append(win_sum / cnt - us[:, :, :, g])
    p = jnp.stack(outs, axis=3)
    y = jnp.einsum('bnlgc,gcd->bnlgd', p, pool_w.astype(jnp.float32))
    return (y.reshape(Bn, L, POOL_WIDTH) * pool_scale.astype(jnp.float32)).astype(u.dtype)


def merge_branches(z, y_a, y_b, proj_a, proj_b, w_out):
    g0 = S5_WIDTH + POOL_WIDTH
    gate_a = jax.nn.sigmoid(z[..., g0:g0 + D_MODEL])
    gate_b = jax.nn.sigmoid(z[..., g0 + D_MODEL:g0 + 2 * D_MODEL])
    return (gate_a * (y_a @ proj_a) + gate_b * (y_b @ proj_b)) @ w_out


def peer_ffn(h, w_q, k1, k2, u_tab, v_tab):
    Bn, L, Dm = h.shape
    blocks = h.reshape((Bn * L) // PEER_BLOCK, PEER_BLOCK, Dm)

    def block_fn(hb):
        q = (hb @ w_q).reshape(PEER_BLOCK, PEER_HEADS, 2, PEER_HALF)
        s1 = jnp.einsum('thd,kd->thk', q[:, :, 0], k1).astype(jnp.float32)
        s2 = jnp.einsum('thd,kd->thk', q[:, :, 1], k2).astype(jnp.float32)
        v1, i1 = lax.top_k(s1, PEER_TOPK)
        v2, i2 = lax.top_k(s2, PEER_TOPK)
        cand = (v1[..., :, None] + v2[..., None, :]).reshape(PEER_BLOCK, PEER_HEADS, PEER_TOPK * PEER_TOPK)
        cid = (i1[..., :, None] * PEER_KEYS + i2[..., None, :]).reshape(PEER_BLOCK, PEER_HEADS, PEER_TOPK * PEER_TOPK)
        top_s, pos = lax.top_k(cand, PEER_TOPK)
        eid = jnp.take_along_axis(cid, pos, axis=-1)
        g = jax.nn.softmax(top_s, axis=-1)
        u_sel = jnp.take(u_tab, eid, axis=0)
        act = jax.nn.gelu(jnp.einsum('td,thkd->thk', hb, u_sel).astype(jnp.float32)) * g
        v_sel = jnp.take(v_tab, eid, axis=0)
        return jnp.einsum('thk,thkd->td', act.astype(hb.dtype), v_sel)

    return lax.map(block_fn, blocks).reshape(Bn, L, Dm)


def setup_inputs(seed: int = 0) -> dict:
    key = jax.random.key(seed)
    ks = jax.random.split(key, 32)

    def nrm(k, shape, s):
        return s * jax.random.normal(k, shape, jnp.float32)

    Ld, G, P, H = DEPTH, S5_GROUPS, S5_STATE, S5_GROUP
    n = jnp.arange(P, dtype=jnp.float32)
    return {
        "x": nrm(ks[0], (BATCH, SEQ, D_MODEL), 1.0),
        "c": nrm(ks[1], (BATCH, D_MODEL), 1.0),
        "ctx": nrm(ks[2], (BATCH, CTX_LEN, D_MODEL), 1.0),
        "c_ctx": nrm(ks[3], (D_MODEL,), 1.0),
        "w_mod": nrm(ks[4], (Ld, D_MODEL, N_MOD * D_MODEL), 0.5 * D_MODEL ** -0.5),
        "b_mod": nrm(ks[5], (Ld, N_MOD * D_MODEL), 0.02),
        "norm1_w": 1.0 + nrm(ks[6], (Ld, D_MODEL), 0.02),
        "norm2_w": 1.0 + nrm(ks[7], (Ld, D_MODEL), 0.02),
        "w_in": nrm(ks[8], (Ld, D_MODEL, IN_WIDTH), D_MODEL ** -0.5),
        "s5_a_re": -0.5 + nrm(ks[9], (Ld, 2, G, P), 0.01),
        "s5_a_im": math.pi * n + nrm(ks[10], (Ld, 2, G, P), 0.01),
        "s5_log_dt": jax.random.uniform(ks[11], (Ld, 2, G), jnp.float32, math.log(1e-3), math.log(1e-1)),
        "s5_b_re": nrm(ks[12], (Ld, 2, G, P, H), (2 * H) ** -0.5),
        "s5_b_im": nrm(ks[13], (Ld, 2, G, P, H), (2 * H) ** -0.5),
        "s5_c_re": nrm(ks[14], (Ld, 2, G, H, P), (2 * P) ** -0.5),
        "s5_c_im": nrm(ks[15], (Ld, 2, G, H, P), (2 * P) ** -0.5),
        "s5_d": nrm(ks[16], (Ld, S5_WIDTH), 0.5),
        "w_glu": nrm(ks[17], (Ld, S5_WIDTH, S5_WIDTH), S5_WIDTH ** -0.5),
        "b_glu": nrm(ks[18], (Ld, S5_WIDTH), 0.02),
        "pool_w": nrm(ks[19], (Ld, POOL_GROUPS, POOL_GROUP_W, POOL_GROUP_W), POOL_GROUP_W ** -0.5),
        "pool_scale": 1.0 + nrm(ks[20], (Ld, POOL_WIDTH), 0.05),
        "proj_a": nrm(ks[21], (Ld, S5_WIDTH, D_MODEL), S5_WIDTH ** -0.5),
        "proj_b": nrm(ks[22], (Ld, POOL_WIDTH, D_MODEL), POOL_WIDTH ** -0.5),
        "w_out": nrm(ks[23], (Ld, D_MODEL, D_MODEL), D_MODEL ** -0.5),
        "peer_wq": nrm(ks[24], (Ld, D_MODEL, PEER_HEADS * PEER_QDIM), D_MODEL ** -0.5),
        "peer_k1": nrm(ks[25], (Ld, PEER_KEYS, PEER_HALF), PEER_HALF ** -0.5),
        "peer_k2": nrm(ks[26], (Ld, PEER_KEYS, PEER_HALF), PEER_HALF ** -0.5),
        "peer_u": nrm(ks[27], (Ld, PEER_EXPERTS, D_MODEL), D_MODEL ** -0.5),
        "peer_v": nrm(ks[28], (Ld, PEER_EXPERTS, D_MODEL), 0.5),
        "final_w": 1.0 + nrm(ks[29], (D_MODEL,), 0.02),
    }


def reference(x, c, ctx, c_ctx, w_mod, b_mod, norm1_w, norm2_w, w_in,
              s5_a_re, s5_a_im, s5_log_dt, s5_b_re, s5_b_im, s5_c_re, s5_c_im, s5_d,
              w_glu, b_glu, pool_w, pool_scale, proj_a, proj_b, w_out,
              peer_wq, peer_k1, peer_k2, peer_u, peer_v, final_w):
    rows = x.shape[1] // GRID_W
    ctx_len = ctx.shape[1]
    for l in range(DEPTH):
        need_ctx = l < DEPTH - 1
        mod_lat = jax.nn.silu(c) @ w_mod[l] + b_mod[l]
        mod_ctx = jax.nn.silu(c_ctx) @ w_mod[l] + b_mod[l]
        sh1, sc1, g1, sh2, sc2, g2 = jnp.split(mod_lat[:, None, :], N_MOD, axis=-1)
        csh1, csc1, cg1, csh2, csc2, cg2 = jnp.split(mod_ctx, N_MOD, axis=-1)

        h = modulate(x, norm1_w[l], sh1, sc1)
        hc = modulate(ctx, norm1_w[l], csh1, csc1)
        z = h @ w_in[l]
        zc = hc @ w_in[l][:, :(IN_WIDTH if need_ctx else S5_WIDTH)]
        y_a, y_a_ctx = s5_branch(z[..., :S5_WIDTH], zc[..., :S5_WIDTH],
                                 s5_a_re[l], s5_a_im[l], s5_log_dt[l], s5_b_re[l], s5_b_im[l],
                                 s5_c_re[l], s5_c_im[l], s5_d[l], w_glu[l], b_glu[l], need_ctx)
        y_b = pool_branch(z[..., S5_WIDTH:S5_WIDTH + POOL_WIDTH], rows, GRID_W, pool_w[l], pool_scale[l])
        x = x + g1 * merge_branches(z, y_a, y_b, proj_a[l], proj_b[l], w_out[l])

        x = x + g2 * peer_ffn(modulate(x, norm2_w[l], sh2, sc2),
                              peer_wq[l], peer_k1[l], peer_k2[l], peer_u[l], peer_v[l])

        if need_ctx:
            y_b_ctx = pool_branch(zc[..., S5_WIDTH:S5_WIDTH + POOL_WIDTH], 1, ctx_len, pool_w[l], pool_scale[l])
            ctx = ctx + cg1 * merge_branches(zc, y_a_ctx, y_b_ctx, proj_a[l], proj_b[l], w_out[l])
            ctx = ctx + cg2 * peer_ffn(modulate(ctx, norm2_w[l], csh2, csc2),
                                       peer_wq[l], peer_k1[l], peer_k2[l], peer_u[l], peer_v[l])
    return rmsnorm(x, final_w)
```

```cpp
#include <hip/hip_runtime.h>
#include <cstdio>
#include <cstdint>

#ifndef Q_I8
#define Q_I8 1
#endif
#ifndef XR_EPI
#define XR_EPI 1
#endif
#ifndef P0_REP
#define P0_REP 0
#endif
#ifndef REP_PHASE
#define REP_PHASE -1
#endif
#ifndef PEER_V2
#define PEER_V2 1
#endif
#ifndef DIAG
#define DIAG 0
#endif
#ifndef MK_ONE_LAUNCH
#define MK_ONE_LAUNCH 1
#endif

#define GAS __attribute__((address_space(1)))
#define LAS __attribute__((address_space(3)))
typedef unsigned short bf16;
typedef unsigned v4u __attribute__((ext_vector_type(4)));
typedef unsigned v2u __attribute__((ext_vector_type(2)));
typedef float f32x4 __attribute__((ext_vector_type(4)));
typedef int i32x4 __attribute__((ext_vector_type(4)));
typedef float f32x2 __attribute__((ext_vector_type(2)));
typedef short bf16x8 __attribute__((ext_vector_type(8)));
typedef __bf16 bf16x2_t __attribute__((ext_vector_type(2)));

constexpr int D = 2048, NB = 4, SEQ = 4096, M = NB * SEQ;
constexpr int CTXL = 256, MC = NB * CTXL, MT = M + MC;
constexpr int INW = 6144, NMOD = 6 * D;
constexpr int S5W = 1024, S5G = 64, S5P = 64, S5H = 16, TCH = 32;
constexpr int NCHL = SEQ / TCH, NCHC = CTXL / TCH;
constexpr int CROWS = 768;
constexpr int USLD = 768;
constexpr int PEER_E = 16384, PEER_H = 8, PEER_K = 16;
constexpr float EPS = 1e-6f;
constexpr int KS_MOD = 32;

constexpr size_t MiB = 1u << 20;
constexpr size_t WS_CTL = 0, CTL_ZERO_BYTES = 1 * MiB;
constexpr size_t WS_MODP = 1 * MiB;
constexpr size_t WS_MOD = 9 * MiB;
constexpr size_t WS_K12 = 10 * MiB;
constexpr size_t WS_XNS = WS_K12 + 384 * 1024, WS_WSC = WS_K12 + 512 * 1024;
constexpr size_t WS_WAM = WS_MODP + 7680 * 1024;
constexpr size_t WS_WAMQ = WS_WAM + 384 * 1024;
constexpr size_t WS_WQSC = WS_K12 + 640 * 1024;
constexpr size_t WS_WIN = 11 * MiB;
constexpr size_t WS_WGLU = 35 * MiB;
constexpr size_t WS_WPOOL = 37 * MiB;
constexpr size_t WS_PROJA = 38 * MiB;
constexpr size_t WS_PROJB = 42 * MiB;
constexpr size_t WS_WOUT = 46 * MiB;
constexpr size_t WS_WQ = 54 * MiB;
constexpr size_t WS_EID = 62 * MiB;
constexpr size_t WS_GW = 70 * MiB;
constexpr size_t WS_A = 78 * MiB;
constexpr size_t WS_B = 206 * MiB;
constexpr size_t WS_C = 278 * MiB;
constexpr size_t WS_D = 346 * MiB;
constexpr size_t WS_E = 394 * MiB;
constexpr size_t WS_F = 410 * MiB;
constexpr size_t WS_G = 458 * MiB;
constexpr size_t WS_I = 490 * MiB;
constexpr size_t WS_T8 = 522 * MiB;
constexpr size_t WS_END = 586 * MiB;
constexpr int CW_TMO = 0, CW_BAR = 4096;
constexpr int CW_UCNT = 96;
constexpr int CW_DNUM = 64, CW_DDEN = 65;

constexpr int LDS_BYTES = 147456;
constexpr int MISC_OFF = LDS_BYTES - 256;
constexpr int TAB_OFF = LDS_BYTES - 1024;
constexpr int NWAVES = 8;
constexpr int NPHASES = 16;

#define RLX_AGENT __ATOMIC_RELAXED, __HIP_MEMORY_SCOPE_AGENT
#define LDS_WAIT() asm volatile("s_waitcnt lgkmcnt(0)" ::: "memory")
#define VM_WAIT() asm volatile("s_waitcnt vmcnt(0)" ::: "memory")
__device__ __forceinline__ unsigned f2bf(float f) { return (unsigned)__builtin_bit_cast(unsigned short, (__bf16)f); }
__device__ __forceinline__ unsigned pk2(float lo, float hi) { return __builtin_bit_cast(unsigned, __builtin_convertvector((f32x2){lo, hi}, bf16x2_t)); }
__device__ __forceinline__ float bflo(unsigned w) { return __builtin_bit_cast(float, w << 16); }
__device__ __forceinline__ float bfhi(unsigned w) { return __builtin_bit_cast(float, w & 0xffff0000u); }
__device__ __forceinline__ float sigmoidf_(float x) { return __builtin_amdgcn_rcpf(1.0f + __expf(-x)); }
__device__ __forceinline__ float gelu_tanh(float x) { const float y = 1.5957691216057308f * (x + 0.044715f * x * x * x); return x * __builtin_amdgcn_rcpf(1.0f + __expf(-y)); }
#define DPP_ADD(v, ctrl) (v) += __builtin_bit_cast(float, __builtin_amdgcn_update_dpp(0, __builtin_bit_cast(int, (v)), (ctrl), 0xf, 0xf, false))
__device__ __forceinline__ float wave_sum(float v) {
    DPP_ADD(v, 0xB1);
    DPP_ADD(v, 0x4E);
    DPP_ADD(v, 0x124);
    DPP_ADD(v, 0x128);
    v += __builtin_bit_cast(float, __builtin_amdgcn_ds_swizzle(__builtin_bit_cast(int, v), 0x401F));
    return __builtin_bit_cast(float, __builtin_amdgcn_readlane(__builtin_bit_cast(int, v), 0)) + __builtin_bit_cast(float, __builtin_amdgcn_readlane(__builtin_bit_cast(int, v), 32));
}
__device__ __forceinline__ float wave_max(float v) {
#define DPP_MAXF(v, ctrl) (v) = fmaxf((v), __builtin_bit_cast(float, __builtin_amdgcn_update_dpp(0, __builtin_bit_cast(int, (v)), (ctrl), 0xf, 0xf, false)))
    DPP_MAXF(v, 0xB1); DPP_MAXF(v, 0x4E); DPP_MAXF(v, 0x124); DPP_MAXF(v, 0x128);
    v = fmaxf(v, __builtin_bit_cast(float, __builtin_amdgcn_ds_swizzle(__builtin_bit_cast(int, v), 0x401F)));
    return fmaxf(__builtin_bit_cast(float, __builtin_amdgcn_readlane(__builtin_bit_cast(int, v), 0)), __builtin_bit_cast(float, __builtin_amdgcn_readlane(__builtin_bit_cast(int, v), 32)));
#undef DPP_MAXF
}
__device__ __forceinline__ float shfl_idx(float v, int src_lane) { return __builtin_bit_cast(float, __builtin_amdgcn_ds_bpermute(src_lane << 2, __builtin_bit_cast(int, v))); }
__device__ __forceinline__ int shfl_idx_i(int v, int src_lane) { return __builtin_amdgcn_ds_bpermute(src_lane << 2, v); }

#ifndef PG8_ALIGN_DEFAULT
#define PG8_ALIGN_DEFAULT true
#endif
#ifndef PG8_SP2_DEFAULT
#define PG8_SP2_DEFAULT true
#endif
namespace pg8 {
constexpr int BM = 256, BK = 64, HALF = 128, HTB = HALF * BK * 2, STAGE_BYTES = 8 * HTB, NXCD = 8, WGM = 8;
__host__ __device__ __forceinline__ int lds_byte(int r, int c) { const int st = (r >> 4) * 2 + (c >> 5), rr = r & 15, cc = c & 31, ob = rr * 64 + cc * 2; return st * 1024 + (ob ^ (((ob >> 9) & 1) << 5)); }
__host__ __device__ __forceinline__ void stage_rc(int b, int& R, int& C) { const int st = b / 1024, sb = b % 1024, swz = sb ^ (((sb >> 9) & 1) << 5); R = (st >> 1) * 16 + swz / 64; C = (st & 1) * 32 + (swz % 64) / 2; }
__host__ __device__ __forceinline__ int perm32(int rho) { const int n = rho >> 4, i = rho & 15; return 8 * (i >> 2) + 4 * n + (i & 3); }
struct Unit { int pm, pn, g; };

__device__ __forceinline__ void std_order(int L, int nM, int nN, int& pm, int& pn) {
    const int nwg = nM * nN; int wgid = L;
    { const int q = nwg / NXCD, r = nwg % NXCD, xcd = wgid % NXCD, off = wgid / NXCD; wgid = (xcd < r ? xcd * (q + 1) : r * (q + 1) + (xcd - r) * q) + off; }
    const int nig = WGM * nN, gid = wgid / nig, fm = gid * WGM, gsz = (nM - fm) < WGM ? (nM - fm) : WGM;
    pm = fm + ((wgid % nig) % gsz); pn = (wgid % nig) / gsz;
}

template <bool ALIGN_EPI = PG8_ALIGN_DEFAULT, bool SP2 = PG8_SP2_DEFAULT, bool I8 = false, class Epi, class Sched>
__device__ __forceinline__ void gemm_phase(const int tid, LAS unsigned char* lds, const Sched& S, const Epi& E, const int K, const int lda, const int ldb) {
    const int wid = __builtin_amdgcn_readfirstlane(tid >> 6), lane = tid & 63, wr = wid >> 2, wc = wid & 3, fr = lane & 15, fq = lane >> 4;
    const int nt = K / BK;
    unsigned voffA[2], voffB[2];
#pragma unroll
    for (int i = 0; i < 2; ++i) { int R, C; stage_rc(tid * 16 + i * 8192, R, C); const int Rb = Epi::PERM ? ((R & ~31) + perm32(R & 31)) : R;
        voffA[i] = (unsigned)(R * lda + C) * 2u; voffB[i] = (unsigned)(Rb * ldb + C) * 2u; }
    const size_t kstep = (size_t)(BK * 2);
    const size_t hstepA = (size_t)HALF * lda * 2, hstepB = (size_t)HALF * ldb * 2;
    const unsigned ldsw = (unsigned)wid * 1024u;
    const int aoff = lds_byte(wr * 64 + fr, fq * 8), boff = lds_byte(wc * 32 + fr, fq * 8);
#define PG8_SA(b, h) (((b) * 2 + (h)) * HTB)
#define PG8_SB(b, h) ((4 + (b) * 2 + (h)) * HTB)
#define PG8_STAGE(bufoff, gbase, voff) do { _Pragma("unroll") for (int _i = 0; _i < 2; ++_i) \
        __builtin_amdgcn_global_load_lds((const unsigned*)((GAS const char*)(gbase) + (voff)[_i]), (LAS unsigned*)(lds + (bufoff) + ldsw + _i * 8192), 16, 0, 0); } while (0)
#define PG8_LDA(dst, b, h) do { _Pragma("unroll") for (int m = 0; m < 4; ++m) _Pragma("unroll") for (int k = 0; k < 2; ++k) dst[m][k] = *(const LAS bf16x8*)(lds + PG8_SA(b, h) + aoff + m * 2048 + k * 1024); } while (0)
#define PG8_LDB(dst, b, h) do { _Pragma("unroll") for (int n = 0; n < 2; ++n) _Pragma("unroll") for (int k = 0; k < 2; ++k) dst[n][k] = *(const LAS bf16x8*)(lds + PG8_SB(b, h) + boff + n * 2048 + k * 1024); } while (0)
#define PG8_MMA(ai, bj, At, Bt) do { __builtin_amdgcn_s_setprio(1); _Pragma("unroll") for (int m = 0; m < 4; ++m) _Pragma("unroll") for (int n = 0; n < 2; ++n) _Pragma("unroll") for (int k = 0; k < 2; ++k) { \
        if constexpr (I8) acc[ai][bj][m][n] = __builtin_bit_cast(f32x4, __builtin_amdgcn_mfma_i32_16x16x64_i8(__builtin_bit_cast(i32x4, Bt[n][k]), __builtin_bit_cast(i32x4, At[m][k]), __builtin_bit_cast(i32x4, acc[ai][bj][m][n]), 0, 0, 0)); \
        else acc[ai][bj][m][n] = __builtin_amdgcn_mfma_f32_16x16x32_bf16(Bt[n][k], At[m][k], acc[ai][bj][m][n], 0, 0, 0); } __builtin_amdgcn_s_setprio(0); } while (0)
#define PG8_WAIT_V(n) asm volatile("s_waitcnt vmcnt(" #n ")" ::: "memory")
#define PG8_WAIT_L(n) asm volatile("s_waitcnt lgkmcnt(" #n ")" ::: "memory")
#define PG8_BAR __builtin_amdgcn_s_barrier()
#define PG8_SCHED __builtin_amdgcn_sched_barrier(0)
    Unit cur, nxt; int ui = 0;
    if (!S.next(0, cur)) return;
    f32x4 acc[2][2][4][2];
#pragma unroll
    for (int a = 0; a < 2; ++a)
#pragma unroll
        for (int b = 0; b < 2; ++b)
#pragma unroll
            for (int m = 0; m < 4; ++m)
#pragma unroll
                for (int n = 0; n < 2; ++n) acc[a][b][m][n] = (f32x4){0.f, 0.f, 0.f, 0.f};
    bf16x8 At[4][2], B0[2][2], B1[2][2];
    GAS const char* cA = S.a_tile(cur); GAS const char* cB = S.b_tile(cur);
    if constexpr (SP2) {
        PG8_STAGE(PG8_SB(0, 0), cB, voffB); PG8_STAGE(PG8_SB(0, 1), cB + hstepB, voffB); PG8_STAGE(PG8_SA(0, 0), cA, voffA); PG8_STAGE(PG8_SA(0, 1), cA + hstepA, voffA);
        if (wr == 1) PG8_BAR;
        PG8_WAIT_V(2); PG8_BAR;
        PG8_STAGE(PG8_SB(1, 0), cB + kstep, voffB); PG8_STAGE(PG8_SA(1, 0), cA + kstep, voffA); PG8_STAGE(PG8_SB(1, 1), cB + hstepB + kstep, voffB);
        PG8_WAIT_V(6); PG8_BAR;
    } else {
        PG8_STAGE(PG8_SB(0, 0), cB, voffB); PG8_STAGE(PG8_SA(0, 0), cA, voffA); PG8_STAGE(PG8_SB(0, 1), cB + hstepB, voffB); PG8_STAGE(PG8_SA(0, 1), cA + hstepA, voffA);
        if (wr == 1) PG8_BAR;
        PG8_WAIT_V(4); PG8_BAR;
        PG8_STAGE(PG8_SB(1, 0), cB + kstep, voffB); PG8_STAGE(PG8_SA(1, 0), cA + kstep, voffA); PG8_STAGE(PG8_SB(1, 1), cB + hstepB + kstep, voffB);
        PG8_WAIT_V(6); PG8_BAR;
    }
    for (;;) {
        const bool has_next = S.next(ui + 1, nxt);
        GAS const char* nA = has_next ? S.a_tile(nxt) : cA; GAS const char* nB = has_next ? S.b_tile(nxt) : cB;
#pragma unroll 1
        for (int t = 0; t < nt; t += 2) {
            const bool last = (t == nt - 2);
            GAS const char* a1 = cA + (size_t)(t + 1) * kstep;
            GAS const char* a2 = last ? nA : cA + (size_t)(t + 2) * kstep; GAS const char* b2 = last ? nB : cB + (size_t)(t + 2) * kstep;
            GAS const char* a3 = a2 + kstep; GAS const char* b3 = b2 + kstep;
            if constexpr (SP2) {
            PG8_LDB(B0, 0, 0); PG8_LDB(B1, 0, 1); PG8_SCHED; PG8_LDA(At, 0, 0); PG8_STAGE(PG8_SA(1, 1), a1 + hstepA, voffA);
            PG8_WAIT_V(8); PG8_WAIT_L(0); PG8_BAR; PG8_MMA(0, 0, At, B0); PG8_MMA(0, 1, At, B1); PG8_BAR; PG8_SCHED;
            PG8_LDA(At, 0, 1); PG8_STAGE(PG8_SB(0, 0), b2, voffB); PG8_STAGE(PG8_SB(0, 1), b2 + hstepB, voffB); PG8_STAGE(PG8_SA(0, 0), a2, voffA);
            PG8_WAIT_V(8); PG8_WAIT_L(0); PG8_BAR; PG8_MMA(1, 0, At, B0); PG8_MMA(1, 1, At, B1); PG8_BAR; PG8_SCHED;
            PG8_LDB(B0, 1, 0); PG8_LDB(B1, 1, 1); PG8_SCHED; PG8_LDA(At, 1, 0); PG8_STAGE(PG8_SA(0, 1), a2 + hstepA, voffA);
            PG8_WAIT_V(8); PG8_WAIT_L(0); PG8_BAR; PG8_MMA(0, 0, At, B0); PG8_MMA(0, 1, At, B1); PG8_BAR; PG8_SCHED;
            PG8_LDA(At, 1, 1); PG8_STAGE(PG8_SB(1, 0), b3, voffB); PG8_STAGE(PG8_SB(1, 1), b3 + hstepB, voffB); PG8_STAGE(PG8_SA(1, 0), a3, voffA);
            PG8_WAIT_V(8); PG8_WAIT_L(0); PG8_BAR; PG8_MMA(1, 0, At, B0); PG8_MMA(1, 1, At, B1); PG8_BAR; PG8_SCHED;
            } else {
            PG8_LDB(B0, 0, 0); PG8_SCHED; PG8_LDA(At, 0, 0); PG8_STAGE(PG8_SA(1, 1), a1 + hstepA, voffA);
            PG8_WAIT_L(8); PG8_BAR; PG8_WAIT_L(0); PG8_MMA(0, 0, At, B0); PG8_BAR; PG8_SCHED;
            PG8_LDB(B1, 0, 1); PG8_STAGE(PG8_SB(0, 0), b2, voffB);
            PG8_BAR; PG8_WAIT_L(0); PG8_MMA(0, 1, At, B1); PG8_BAR;
            PG8_LDA(At, 0, 1); PG8_STAGE(PG8_SA(0, 0), a2, voffA);
            PG8_BAR; PG8_WAIT_L(0); PG8_MMA(1, 0, At, B0); PG8_BAR; PG8_SCHED;
            PG8_STAGE(PG8_SB(0, 1), b2 + hstepB, voffB);
            PG8_WAIT_V(6); PG8_BAR; PG8_MMA(1, 1, At, B1); PG8_BAR;
            PG8_LDB(B0, 1, 0); PG8_SCHED; PG8_LDA(At, 1, 0); PG8_STAGE(PG8_SA(0, 1), a2 + hstepA, voffA);
            PG8_WAIT_L(8); PG8_BAR; PG8_WAIT_L(0); PG8_MMA(0, 0, At, B0); PG8_BAR; PG8_SCHED;
            PG8_LDB(B1, 1, 1); PG8_STAGE(PG8_SB(1, 0), b3, voffB);
            PG8_BAR; PG8_WAIT_L(0); PG8_MMA(0, 1, At, B1); PG8_BAR;
            PG8_LDA(At, 1, 1); PG8_STAGE(PG8_SA(1, 0), a3, voffA);
            PG8_BAR; PG8_WAIT_L(0); PG8_MMA(1, 0, At, B0); PG8_BAR; PG8_SCHED;
            PG8_STAGE(PG8_SB(1, 1), b3 + hstepB, voffB);
            PG8_WAIT_V(6); PG8_BAR; PG8_MMA(1, 1, At, B1); PG8_BAR;
            }
        }
        if constexpr (ALIGN_EPI) { if (wr == 0) PG8_BAR; }
        bool keep = false;
        if constexpr (Epi::DUAL) { if (cur.g == 0) { E.mid(acc, cur, wr, wc, fr, fq); keep = true; } else E(acc, cur, wr, wc, fr, fq); }
        else E(acc, cur, wr, wc, fr, fq);
        if (!has_next) break;
        if (!keep) {
#pragma unroll
        for (int a = 0; a < 2; ++a)
#pragma unroll
            for (int b = 0; b < 2; ++b)
#pragma unroll
                for (int m = 0; m < 4; ++m)
#pragma unroll
                    for (int n = 0; n < 2; ++n) acc[a][b][m][n] = (f32x4){0.f, 0.f, 0.f, 0.f};
        }
        cur = nxt; cA = nA; cB = nB; ++ui;
        if constexpr (ALIGN_EPI) { if (wr == 1) PG8_BAR; }
    }
    PG8_WAIT_V(0);
    if constexpr (!ALIGN_EPI) { if (wr == 0) PG8_BAR; }
    PG8_BAR;
#undef PG8_SA
#undef PG8_SB
#undef PG8_STAGE
#undef PG8_LDA
#undef PG8_LDB
#undef PG8_MMA
#undef PG8_WAIT_V
#undef PG8_WAIT_L
#undef PG8_BAR
#undef PG8_SCHED
}
}
using pg8::Unit;

#define XB_TMO      128
#define XB_XCNT(j)  (256  + 64 * (j))
#define XB_XSUB(j)  (1280 + 64 * (j))
#define XB_XGEN(j)  (2304 + 64 * (j))
#define XB_TOP      3328
#define XB_TOPGEN   3392
#define XCD_BAR_WORDS 3456
#define XB_SPIN_CAP (1u << 20)
__device__ __forceinline__ unsigned xb_ld(unsigned* p)              { return __hip_atomic_load(p, __ATOMIC_RELAXED, __HIP_MEMORY_SCOPE_AGENT); }
__device__ __forceinline__ unsigned xb_add(unsigned* p, unsigned v) { return __hip_atomic_fetch_add(p, v, __ATOMIC_RELAXED, __HIP_MEMORY_SCOPE_AGENT); }
__device__ __forceinline__ unsigned xb_xcc_id() { return (unsigned)__builtin_amdgcn_s_getreg((3 << 11) | 20) & 0xFu; }
#define XB_SPIN(cond, bar) do { unsigned _sp = 0; while (cond) { __builtin_amdgcn_s_sleep(1); \
    if ((++_sp & 255u) == 0u) { if (xb_ld(&(bar)[XB_TMO])) break; if (_sp > XB_SPIN_CAP) { atomicAdd(&(bar)[XB_TMO], 1u); break; } } } } while (0)
struct XcdBarrier { unsigned* bar; unsigned x; volatile LAS unsigned* st; };
__device__ __forceinline__ XcdBarrier xcd_barrier_post(unsigned* bar, volatile LAS unsigned* st) {
    XcdBarrier b; b.bar = bar; b.x = xb_xcc_id(); b.st = st;
    if (threadIdx.x == 0) (void)xb_add(&bar[XB_XCNT(b.x)], 1u);
    return b;
}
__device__ __forceinline__ void xcd_barrier_complete(unsigned* bar, unsigned x, unsigned& nloc, unsigned& nx) {
    const unsigned G = gridDim.x * gridDim.y * gridDim.z;
    unsigned sum, cnt, mine, sp = 0u;
    for (;;) {
        sum = 0u; cnt = 0u; mine = 0u;
#pragma unroll
        for (unsigned j = 0; j < 16; ++j) { const unsigned c = xb_ld(&bar[XB_XCNT(j)]); sum += c; cnt += (c > 0u) ? 1u : 0u; mine = (j == x) ? c : mine; }
        if (sum == G) break;
        __builtin_amdgcn_s_sleep(1);
        if ((++sp & 255u) == 0u) { if (xb_ld(&bar[XB_TMO])) break; if (sp > XB_SPIN_CAP) { atomicAdd(&bar[XB_TMO], 1u); break; } }
    }
    nloc = mine > 0u ? mine : 1u; nx = cnt > 0u ? cnt : 1u;
}
__device__ __forceinline__ void xcd_barrier(const XcdBarrier& b, const int tid) {
    asm volatile("s_waitcnt vmcnt(0)" ::: "memory");
    __syncthreads();
    if (tid == 0) {
        unsigned* bar = b.bar;
        __builtin_amdgcn_s_waitcnt(0);
        unsigned nloc = b.st[0], nx = b.st[1];
        if (nloc == 0u) { xcd_barrier_complete(bar, b.x, nloc, nx); b.st[0] = nloc; b.st[1] = nx; }
        const unsigned old = xb_add(&bar[XB_XSUB(b.x)], 1u);
        const unsigned gen = old / nloc;
        if (old + 1u == (gen + 1u) * nloc) {
            __builtin_amdgcn_fence(__ATOMIC_RELEASE, "agent");
            asm volatile("s_waitcnt vmcnt(0)" ::: "memory");
            const unsigned og = xb_add(&bar[XB_TOP], 1u);
            const unsigned tg = og / nx;
            if (og + 1u == (tg + 1u) * nx) xb_add(&bar[XB_TOPGEN], 1u);
            else XB_SPIN(xb_ld(&bar[XB_TOPGEN]) == tg, bar);
            __builtin_amdgcn_fence(__ATOMIC_ACQUIRE, "agent");
            xb_add(&bar[XB_XGEN(b.x)], 1u);
            asm volatile("s_waitcnt vmcnt(0)" ::: "memory");
        } else {
            XB_SPIN(xb_ld(&bar[XB_XGEN(b.x)]) == gen, bar);
            __builtin_amdgcn_fence(__ATOMIC_ACQUIRE, "agent");
            asm volatile("s_waitcnt vmcnt(0)" ::: "memory");
        }
    }
    __syncthreads();
}

struct Args { const float* in[30]; float* out; unsigned char* ws; int ph_lo, ph_hi; };
struct Frame {
    LAS unsigned char* lds;
    int tid, lane, wave, wave0, vcu, G, gw, NGW;
    GAS float* out; GAS unsigned char* ws;
    __device__ __forceinline__ GAS const float* inp(int i) const { return (GAS const float*)(((volatile LAS unsigned long long*)(lds + TAB_OFF))[i]); }
};

__device__ __forceinline__ bool frame_refresh(Frame& F) { unsigned z = 0u; asm volatile("" : "+v"(z));
    int t = (F.wave0 << 6) | (int)__builtin_amdgcn_mbcnt_hi(~0u, __builtin_amdgcn_mbcnt_lo(~0u, z));
    F.tid = t; F.lane = t & 63; F.wave = __builtin_amdgcn_readfirstlane(t >> 6); F.gw = F.vcu * NWAVES + F.wave; return true; }
struct SchedStd {
    GAS const char* A; GAS const char* Bt; int nM, nN, G, c; size_t tA, tB;
    __device__ __forceinline__ bool next(int i, Unit& u) const { const int L = i * G + c; if (L >= nM * nN) return false; pg8::std_order(L, nM, nN, u.pm, u.pn); u.g = 0; return true; }
    __device__ __forceinline__ GAS const char* a_tile(const Unit& u) const { return A + (size_t)u.pm * tA; }
    __device__ __forceinline__ GAS const char* b_tile(const Unit& u) const { return Bt + (size_t)u.pn * tB; }
};
struct SchedZ {
    GAS const char* A; GAS const char* Bt; int G, c;
    __device__ __forceinline__ bool next(int i, Unit& u) const { const int L = i * G + c; if (L >= 1536 + 16) return false;
        if (L < 1536) pg8::std_order(L, 64, 24, u.pm, u.pn); else { const int q = L - 1536; u.pm = 64 + (q >> 2); u.pn = q & 3; } u.g = 0; return true; }
    __device__ __forceinline__ GAS const char* a_tile(const Unit& u) const { return A + (size_t)u.pm * (256 * D); }
    __device__ __forceinline__ GAS const char* b_tile(const Unit& u) const { return Bt + (size_t)u.pn * (256 * D); }
};
struct SchedS5a {
    GAS const char* US; GAS const char* EB; int G, c;
    __device__ __forceinline__ bool next(int i, Unit& u) const { const int L = i * G + c; if (L >= S5G * 3) return false; u.g = L / 3; u.pm = L % 3; u.pn = 0; return true; }
    __device__ __forceinline__ GAS const char* a_tile(const Unit& u) const { return US + ((size_t)u.g * CROWS + u.pm * 256) * (USLD * 2); }
    __device__ __forceinline__ GAS const char* b_tile(const Unit& u) const { return EB + (size_t)u.g * (256 * 512 * 2); }
};
struct SchedS5c {
    GAS const char* US; GAS const char* TB; int G, c;
    __device__ __forceinline__ bool next(int i, Unit& u) const { const int L = i * G + c; if (L >= S5G * 4) return false; u.g = L >> 2; u.pm = (L >> 1) & 1; u.pn = L & 1; return true; }
    __device__ __forceinline__ GAS const char* a_tile(const Unit& u) const { return US + ((size_t)u.g * CROWS + u.pm * 256) * (USLD * 2); }
    __device__ __forceinline__ GAS const char* b_tile(const Unit& u) const { return TB + ((size_t)u.g * 512 + u.pn * 256) * (768 * 2); }
};
struct SchedPool {
    GAS const char* PP; GAS const char* WP; int G, c;
    __device__ __forceinline__ bool next(int i, Unit& u) const { const int L = i * G + c; if (L >= 256) return false; u.pm = L >> 2; u.pn = L & 3; u.g = 0; return true; }
    __device__ __forceinline__ GAS const char* a_tile(const Unit& u) const { return PP + ((size_t)u.pm * 256 * 1024 + u.pn * 256) * 2; }
    __device__ __forceinline__ GAS const char* b_tile(const Unit& u) const { return WP + (size_t)u.pn * (256 * 256 * 2); }
};

#define EPI_LOOP_AI_M for (int ai = 0; ai < 2; ++ai) _Pragma("unroll") for (int m = 0; m < 4; ++m)
struct EpiZ {
    static constexpr bool PERM = true, DUAL = false;
    GAS bf16* US; GAS bf16* ZP; GAS bf16* GATES; GAS const float* XNS; GAS const float* WSC;
    __device__ __forceinline__ void operator()(const f32x4 (&acc)[2][2][4][2], const Unit& u, int wr, int wc, int fr, int fq) const {
        f32x4 wsc[2][2]; float rsv[2][4];
#pragma unroll
        for (int bj = 0; bj < 2; ++bj) { const int col = u.pn * 256 + bj * 128 + wc * 32 + 8 * fq; wsc[bj][0] = *(GAS const f32x4*)(WSC + col); wsc[bj][1] = *(GAS const f32x4*)(WSC + col + 4); }
#pragma unroll
        for (int ai = 0; ai < 2; ++ai)
#pragma unroll
            for (int m = 0; m < 4; ++m) rsv[ai][m] = XNS[u.pm * 256 + ai * 128 + wr * 64 + m * 16 + fr];
#pragma unroll
        EPI_LOOP_AI_M {
            const int rl = ai * 128 + wr * 64 + m * 16 + fr;
            const float rs = rsv[ai][m];
#pragma unroll
            for (int bj = 0; bj < 2; ++bj) {
                const int col = u.pn * 256 + bj * 128 + wc * 32 + 8 * fq;
                const i32x4 i0 = __builtin_bit_cast(i32x4, acc[ai][bj][m][0]), i1 = __builtin_bit_cast(i32x4, acc[ai][bj][m][1]);
                const f32x4 s0 = wsc[bj][0] * rs, s1 = wsc[bj][1] * rs;
                f32x4 v0 = (f32x4){(float)i0.x, (float)i0.y, (float)i0.z, (float)i0.w} * s0, v1 = (f32x4){(float)i1.x, (float)i1.y, (float)i1.z, (float)i1.w} * s1;
                GAS bf16* dst;
                if (u.pn < 4) {
                    int crow, s;
                    if (u.pm < 64) { const int tok = u.pm * 256 + rl; const int b = tok >> 12, tp = tok & 4095; crow = b * NCHL + (tp >> 5); s = tp & 31; }
                    else { const int rc = (u.pm - 64) * 256 + rl; const int b = rc >> 8, tp = rc & 255; crow = 512 + b * NCHC + (tp >> 5); s = tp & 31; }
                    const int g = col >> 4, hh = col & 15;
                    dst = US + ((size_t)g * CROWS + crow) * USLD + s * 16 + hh;
                } else if (u.pn < 8) {
                    dst = ZP + (size_t)(u.pm * 256 + rl) * 1024 + (col - 1024);
                } else {
#pragma unroll
                    for (int j = 0; j < 4; ++j) { v0[j] = sigmoidf_(v0[j]); v1[j] = sigmoidf_(v1[j]); }
                    dst = GATES + (size_t)(u.pm * 256 + rl) * 4096 + (col - 2048);
                }
                v4u w; w.x = pk2(v0[0], v0[1]); w.y = pk2(v0[2], v0[3]); w.z = pk2(v1[0], v1[1]); w.w = pk2(v1[2], v1[3]);
                *(GAS v4u*)dst = w;
            }
        }
    }
};
struct EpiHloc {
    static constexpr bool PERM = false, DUAL = false;
    GAS float* HL;
    __device__ __forceinline__ void operator()(const f32x4 (&acc)[2][2][4][2], const Unit& u, int wr, int wc, int fr, int fq) const {
#pragma unroll
        EPI_LOOP_AI_M {
            const int row = u.pm * 256 + ai * 128 + wr * 64 + m * 16 + fr;
            GAS float* rp = HL + ((size_t)u.g * CROWS + row) * 256 + wc * 32 + 4 * fq;
#pragma unroll
            for (int bj = 0; bj < 2; ++bj)
#pragma unroll
                for (int n = 0; n < 2; ++n) *(GAS f32x4*)(rp + bj * 128 + n * 16) = acc[ai][bj][m][n];
        }
    }
};
struct EpiS5c {
    static constexpr bool PERM = true, DUAL = false;
    GAS const bf16* US; GAS bf16* G1; GAS const float* dskip; GAS const float* YN; unsigned* CTLW;
    __device__ __forceinline__ void operator()(const f32x4 (&acc)[2][2][4][2], const Unit& u, int wr, int wc, int fr, int fq) const {
        float dnum = 0.f, dden = 0.f;
        const int h0 = (8 * fq) & 15;
        const f32x4 d0 = *(GAS const f32x4*)(dskip + u.g * 16 + h0), d1 = *(GAS const f32x4*)(dskip + u.g * 16 + h0 + 4);
#pragma unroll
        for (int ai = 0; ai < 2; ++ai) {
        v4u uwv[4][2];
#pragma unroll
        for (int m = 0; m < 4; ++m)
#pragma unroll
            for (int bj = 0; bj < 2; ++bj) uwv[m][bj] = *(GAS const v4u*)(US + ((size_t)u.g * CROWS + u.pm * 256 + ai * 128 + wr * 64 + m * 16 + fr) * USLD + u.pn * 256 + bj * 128 + wc * 32 + 8 * fq);
#pragma unroll
        for (int m = 0; m < 4; ++m) {
            const int crow = u.pm * 256 + ai * 128 + wr * 64 + m * 16 + fr;
            const int b = crow >> 7, ch = crow & 127;
#pragma unroll
            for (int bj = 0; bj < 2; ++bj) {
                const int col = u.pn * 256 + bj * 128 + wc * 32 + 8 * fq;
                const int t = col >> 4;
                const v4u uw = uwv[m][bj];
                f32x4 v0 = acc[ai][bj][m][0], v1 = acc[ai][bj][m][1];
                if (DIAG == 5) { v0 = (f32x4){0.f, 0.f, 0.f, 0.f}; v1 = v0; }
                if (DIAG == 6) { v0 = -v0; v1 = -v1; }
                if (DIAG == 10 || DIAG == 11) { GAS const float* yn = YN + ((size_t)b * SEQ + ch * TCH + t) * S5W + u.g * 16 + h0; const f32x4 r0 = *(GAS const f32x4*)yn, r1 = *(GAS const f32x4*)(yn + 4);
                    const f32x4 e0 = v0 - r0, e1 = v1 - r1; dnum += e0.x * e0.x + e0.y * e0.y + e0.z * e0.z + e0.w * e0.w + e1.x * e1.x + e1.y * e1.y + e1.z * e1.z + e1.w * e1.w; dden += r0.x * r0.x + r0.y * r0.y + r0.z * r0.z + r0.w * r0.w + r1.x * r1.x + r1.y * r1.y + r1.z * r1.z + r1.w * r1.w; }
                float o[8];
                o[0] = v0[0] + d0[0] * bflo(uw.x); o[1] = v0[1] + d0[1] * bfhi(uw.x); o[2] = v0[2] + d0[2] * bflo(uw.y); o[3] = v0[3] + d0[3] * bfhi(uw.y);
                o[4] = v1[0] + d1[0] * bflo(uw.z); o[5] = v1[1] + d1[1] * bfhi(uw.z); o[6] = v1[2] + d1[2] * bflo(uw.w); o[7] = v1[3] + d1[3] * bfhi(uw.w);
#pragma unroll
                for (int j = 0; j < 8; ++j) o[j] = gelu_tanh(o[j]);
                const size_t tok = (size_t)b * SEQ + ch * TCH + t;
                v4u w; w.x = pk2(o[0], o[1]); w.y = pk2(o[2], o[3]); w.z = pk2(o[4], o[5]); w.w = pk2(o[6], o[7]);
                *(GAS v4u*)(G1 + tok * S5W + u.g * 16 + h0) = w;
            }
        }
        asm volatile("" ::: "memory");
        }
        if (DIAG == 10 || DIAG == 11) { dnum = wave_sum(dnum); dden = wave_sum(dden); if ((threadIdx.x & 63) == 0) { atomicAdd((float*)CTLW + CW_DNUM, dnum); atomicAdd((float*)CTLW + CW_DDEN, dden); } }
    }
};
struct EpiPool {
    static constexpr bool PERM = true, DUAL = false;
    GAS bf16* YB; GAS const float* scale;
    __device__ __forceinline__ void operator()(const f32x4 (&acc)[2][2][4][2], const Unit& u, int wr, int wc, int fr, int fq) const {
        f32x4 sv[2][2];
#pragma unroll
        for (int bj = 0; bj < 2; ++bj) { const int col = u.pn * 256 + bj * 128 + wc * 32 + 8 * fq; sv[bj][0] = *(GAS const f32x4*)(scale + col); sv[bj][1] = *(GAS const f32x4*)(scale + col + 4); }
#pragma unroll
        EPI_LOOP_AI_M {
            const int row = u.pm * 256 + ai * 128 + wr * 64 + m * 16 + fr;
#pragma unroll
            for (int bj = 0; bj < 2; ++bj) {
                const int col = u.pn * 256 + bj * 128 + wc * 32 + 8 * fq;
                const f32x4 v0 = acc[ai][bj][m][0] * sv[bj][0], v1 = acc[ai][bj][m][1] * sv[bj][1];
                v4u w; w.x = pk2(v0[0], v0[1]); w.y = pk2(v0[2], v0[3]); w.z = pk2(v1[0], v1[1]); w.w = pk2(v1[2], v1[3]);
                *(GAS v4u*)(YB + (size_t)row * 1024 + col) = w;
            }
        }
    }
};
struct EpiGlu {
    static constexpr bool PERM = true, DUAL = false;
    GAS const bf16* G1; GAS bf16* YA; GAS const float* bias;
    __device__ __forceinline__ void operator()(const f32x4 (&acc)[2][2][4][2], const Unit& u, int wr, int wc, int fr, int fq) const {
        f32x4 bv[2][2];
#pragma unroll
        for (int bj = 0; bj < 2; ++bj) { const int col = u.pn * 256 + bj * 128 + wc * 32 + 8 * fq; bv[bj][0] = *(GAS const f32x4*)(bias + col); bv[bj][1] = *(GAS const f32x4*)(bias + col + 4); }
#pragma unroll
        for (int ai = 0; ai < 2; ++ai) {
            v4u gv[4][2];
#pragma unroll
            for (int m = 0; m < 4; ++m)
#pragma unroll
                for (int bj = 0; bj < 2; ++bj) gv[m][bj] = *(GAS const v4u*)(G1 + (size_t)(u.pm * 256 + ai * 128 + wr * 64 + m * 16 + fr) * 1024 + u.pn * 256 + bj * 128 + wc * 32 + 8 * fq);
#pragma unroll
            for (int m = 0; m < 4; ++m) {
                const int row = u.pm * 256 + ai * 128 + wr * 64 + m * 16 + fr;
#pragma unroll
                for (int bj = 0; bj < 2; ++bj) {
                    const int col = u.pn * 256 + bj * 128 + wc * 32 + 8 * fq;
                    const v4u gw = gv[m][bj];
                    const f32x4 v0 = acc[ai][bj][m][0] + bv[bj][0], v1 = acc[ai][bj][m][1] + bv[bj][1];
                    float o[8];
                    o[0] = bflo(gw.x) * sigmoidf_(v0[0]); o[1] = bfhi(gw.x) * sigmoidf_(v0[1]); o[2] = bflo(gw.y) * sigmoidf_(v0[2]); o[3] = bfhi(gw.y) * sigmoidf_(v0[3]);
                    o[4] = bflo(gw.z) * sigmoidf_(v1[0]); o[5] = bfhi(gw.z) * sigmoidf_(v1[1]); o[6] = bflo(gw.w) * sigmoidf_(v1[2]); o[7] = bfhi(gw.w) * sigmoidf_(v1[3]);
                    v4u w; w.x = pk2(o[0], o[1]); w.y = pk2(o[2], o[3]); w.z = pk2(o[4], o[5]); w.w = pk2(o[6], o[7]);
                    *(GAS v4u*)(YA + (size_t)row * 1024 + col) = w;
                }
            }
            asm volatile("" ::: "memory");
        }
    }
};
template <int MODE> struct EpiMerge {
    static constexpr bool PERM = true, DUAL = false;
    GAS const bf16* GATES; GAS const bf16* T1in; GAS bf16* OUT;
    __device__ __forceinline__ void operator()(const f32x4 (&acc)[2][2][4][2], const Unit& u, int wr, int wc, int fr, int fq) const {
#pragma unroll
        EPI_LOOP_AI_M {
            const int row = u.pm * 256 + ai * 128 + wr * 64 + m * 16 + fr;
#pragma unroll
            for (int bj = 0; bj < 2; ++bj) {
                const int col = u.pn * 256 + bj * 128 + wc * 32 + 8 * fq;
                const v4u gt = *(GAS const v4u*)(GATES + (size_t)row * 4096 + MODE * 2048 + col);
                const f32x4 v0 = acc[ai][bj][m][0], v1 = acc[ai][bj][m][1];
                float o[8];
                o[0] = bflo(gt.x) * v0[0]; o[1] = bfhi(gt.x) * v0[1]; o[2] = bflo(gt.y) * v0[2]; o[3] = bfhi(gt.y) * v0[3];
                o[4] = bflo(gt.z) * v1[0]; o[5] = bfhi(gt.z) * v1[1]; o[6] = bflo(gt.w) * v1[2]; o[7] = bfhi(gt.w) * v1[3];
                if (MODE == 1) {
                    const v4u tw = *(GAS const v4u*)(T1in + (size_t)row * 2048 + col);
                    o[0] += bflo(tw.x); o[1] += bfhi(tw.x); o[2] += bflo(tw.y); o[3] += bfhi(tw.y); o[4] += bflo(tw.z); o[5] += bfhi(tw.z); o[6] += bflo(tw.w); o[7] += bfhi(tw.w);
                }
                v4u w; w.x = pk2(o[0], o[1]); w.y = pk2(o[2], o[3]); w.z = pk2(o[4], o[5]); w.w = pk2(o[6], o[7]);
                *(GAS v4u*)(OUT + (size_t)row * 2048 + col) = w;
                asm volatile("" ::: "memory");
            }
        }
    }
};

struct EpiMerge2 {
    static constexpr bool PERM = true, DUAL = true;
    GAS const bf16* GATES; GAS bf16* OUT;
    __device__ __forceinline__ void mid(f32x4 (&acc)[2][2][4][2], const Unit& u, int wr, int wc, int fr, int fq) const {
#define GBC(x) fmaxf((x), 1e-30f)
#pragma unroll
        for (int ai = 0; ai < 2; ++ai) {
            v4u gav[4][2], gbv[4][2];
#pragma unroll
            for (int m = 0; m < 4; ++m)
#pragma unroll
                for (int bj = 0; bj < 2; ++bj) { GAS const bf16* gp = GATES + (size_t)(u.pm * 256 + ai * 128 + wr * 64 + m * 16 + fr) * 4096 + u.pn * 256 + bj * 128 + wc * 32 + 8 * fq;
                    gav[m][bj] = *(GAS const v4u*)gp; gbv[m][bj] = *(GAS const v4u*)(gp + 2048); }
#pragma unroll
            for (int m = 0; m < 4; ++m)
#pragma unroll
                for (int bj = 0; bj < 2; ++bj) { const v4u ga = gav[m][bj], gb = gbv[m][bj];
                    f32x4 r0, r1;
                    r0[0] = bflo(ga.x) * __builtin_amdgcn_rcpf(GBC(bflo(gb.x))); r0[1] = bfhi(ga.x) * __builtin_amdgcn_rcpf(GBC(bfhi(gb.x))); r0[2] = bflo(ga.y) * __builtin_amdgcn_rcpf(GBC(bflo(gb.y))); r0[3] = bfhi(ga.y) * __builtin_amdgcn_rcpf(GBC(bfhi(gb.y)));
                    r1[0] = bflo(ga.z) * __builtin_amdgcn_rcpf(GBC(bflo(gb.z))); r1[1] = bfhi(ga.z) * __builtin_amdgcn_rcpf(GBC(bfhi(gb.z))); r1[2] = bflo(ga.w) * __builtin_amdgcn_rcpf(GBC(bflo(gb.w))); r1[3] = bfhi(ga.w) * __builtin_amdgcn_rcpf(GBC(bfhi(gb.w)));
                    acc[ai][bj][m][0] *= r0; acc[ai][bj][m][1] *= r1; }
            asm volatile("" ::: "memory");
        }
    }
    __device__ __forceinline__ void operator()(const f32x4 (&acc)[2][2][4][2], const Unit& u, int wr, int wc, int fr, int fq) const {
#pragma unroll
        for (int ai = 0; ai < 2; ++ai) {
            v4u gbv[4][2];
#pragma unroll
            for (int m = 0; m < 4; ++m)
#pragma unroll
                for (int bj = 0; bj < 2; ++bj) gbv[m][bj] = *(GAS const v4u*)(GATES + (size_t)(u.pm * 256 + ai * 128 + wr * 64 + m * 16 + fr) * 4096 + 2048 + u.pn * 256 + bj * 128 + wc * 32 + 8 * fq);
#pragma unroll
            for (int m = 0; m < 4; ++m) {
                const int row = u.pm * 256 + ai * 128 + wr * 64 + m * 16 + fr;
#pragma unroll
                for (int bj = 0; bj < 2; ++bj) {
                    const int col = u.pn * 256 + bj * 128 + wc * 32 + 8 * fq;
                    const v4u gt = gbv[m][bj];
                    const f32x4 v0 = acc[ai][bj][m][0], v1 = acc[ai][bj][m][1];
                    v4u w; w.x = pk2(GBC(bflo(gt.x)) * v0[0], GBC(bfhi(gt.x)) * v0[1]); w.y = pk2(GBC(bflo(gt.y)) * v0[2], GBC(bfhi(gt.y)) * v0[3]); w.z = pk2(GBC(bflo(gt.z)) * v1[0], GBC(bfhi(gt.z)) * v1[1]); w.w = pk2(GBC(bflo(gt.w)) * v1[2], GBC(bfhi(gt.w)) * v1[3]);
                    *(GAS v4u*)(OUT + (size_t)row * 2048 + col) = w;
                }
            }
            asm volatile("" ::: "memory");
        }
    }
};
struct SchedMerge {
    GAS const char* YA; GAS const char* YB; GAS const char* PA; GAS const char* PB; int G, c;
    __device__ __forceinline__ bool next(int i, Unit& u) const { const int L = (i >> 1) * G + c; if (L >= 512) return false; pg8::std_order(L, 64, 8, u.pm, u.pn); u.g = i & 1; return true; }
    __device__ __forceinline__ GAS const char* a_tile(const Unit& u) const { return (u.g ? YB : YA) + (size_t)u.pm * (256 * 1024 * 2); }
    __device__ __forceinline__ GAS const char* b_tile(const Unit& u) const { return (u.g ? PB : PA) + (size_t)u.pn * (256 * 1024 * 2); }
};
struct EpiWout {
    static constexpr bool PERM = true, DUAL = false;
    GAS bf16* D1; GAS const float* MOD; GAS const float* X;
    __device__ __forceinline__ void operator()(const f32x4 (&acc)[2][2][4][2], const Unit& u, int wr, int wc, int fr, int fq) const {
        const int b = u.pm >> 4;
        GAS const float* g1 = MOD + (size_t)b * NMOD + 2 * D;
        f32x4 g1v[2][2];
#pragma unroll
        for (int bj = 0; bj < 2; ++bj) { const int col = u.pn * 256 + bj * 128 + wc * 32 + 8 * fq; g1v[bj][0] = *(GAS const f32x4*)(g1 + col); g1v[bj][1] = *(GAS const f32x4*)(g1 + col + 4); }
#pragma unroll
        for (int ai = 0; ai < 2; ++ai) {
            f32x4 xv[4][2][2];
            if (XR_EPI) {
#pragma unroll
                for (int m = 0; m < 4; ++m)
#pragma unroll
                    for (int bj = 0; bj < 2; ++bj) { GAS const float* xp = X + (size_t)(u.pm * 256 + ai * 128 + wr * 64 + m * 16 + fr) * D + u.pn * 256 + bj * 128 + wc * 32 + 8 * fq;
                        xv[m][bj][0] = *(GAS const f32x4*)xp; xv[m][bj][1] = *(GAS const f32x4*)(xp + 4); }
            }
#pragma unroll
            for (int m = 0; m < 4; ++m) {
                const int row = u.pm * 256 + ai * 128 + wr * 64 + m * 16 + fr;
#pragma unroll
                for (int bj = 0; bj < 2; ++bj) {
                    const int col = u.pn * 256 + bj * 128 + wc * 32 + 8 * fq;
                    f32x4 v0 = acc[ai][bj][m][0] * g1v[bj][0], v1 = acc[ai][bj][m][1] * g1v[bj][1];
                    if (XR_EPI) { v0 += xv[m][bj][0]; v1 += xv[m][bj][1]; }
                    v4u w; w.x = pk2(v0[0], v0[1]); w.y = pk2(v0[2], v0[3]); w.z = pk2(v1[0], v1[1]); w.w = pk2(v1[2], v1[3]);
                    *(GAS v4u*)(D1 + (size_t)row * D + col) = w;
                }
            }
        }
    }
};
struct EpiQ {
    static constexpr bool PERM = true, DUAL = false;
    GAS bf16* Q;
    __device__ __forceinline__ void operator()(const f32x4 (&acc)[2][2][4][2], const Unit& u, int wr, int wc, int fr, int fq) const {
#pragma unroll
        EPI_LOOP_AI_M {
            const int row = u.pm * 256 + ai * 128 + wr * 64 + m * 16 + fr;
#pragma unroll
            for (int bj = 0; bj < 2; ++bj) {
                const int col = u.pn * 256 + bj * 128 + wc * 32 + 8 * fq;
                const f32x4 v0 = acc[ai][bj][m][0], v1 = acc[ai][bj][m][1];
                v4u w; w.x = pk2(v0[0], v0[1]); w.y = pk2(v0[2], v0[3]); w.z = pk2(v1[0], v1[1]); w.w = pk2(v1[2], v1[3]);
                *(GAS v4u*)(Q + (size_t)row * D + col) = w;
            }
        }
    }
};

struct EpiQ8 {
    static constexpr bool PERM = true, DUAL = false;
    GAS bf16* Q; GAS const float* HSC; GAS const float* WQSC;
    __device__ __forceinline__ void operator()(const f32x4 (&acc)[2][2][4][2], const Unit& u, int wr, int wc, int fr, int fq) const {
        f32x4 wsc[2][2]; float rsv[2][4];
#pragma unroll
        for (int bj = 0; bj < 2; ++bj) { const int col = u.pn * 256 + bj * 128 + wc * 32 + 8 * fq; wsc[bj][0] = *(GAS const f32x4*)(WQSC + col); wsc[bj][1] = *(GAS const f32x4*)(WQSC + col + 4); }
#pragma unroll
        for (int ai = 0; ai < 2; ++ai)
#pragma unroll
            for (int m = 0; m < 4; ++m) rsv[ai][m] = HSC[u.pm * 256 + ai * 128 + wr * 64 + m * 16 + fr];
#pragma unroll
        EPI_LOOP_AI_M {
            const int row = u.pm * 256 + ai * 128 + wr * 64 + m * 16 + fr;
            const float rs = rsv[ai][m];
#pragma unroll
            for (int bj = 0; bj < 2; ++bj) {
                const int col = u.pn * 256 + bj * 128 + wc * 32 + 8 * fq;
                const i32x4 i0 = __builtin_bit_cast(i32x4, acc[ai][bj][m][0]), i1 = __builtin_bit_cast(i32x4, acc[ai][bj][m][1]);
                const f32x4 s0 = wsc[bj][0] * rs, s1 = wsc[bj][1] * rs;
                const f32x4 v0 = (f32x4){(float)i0.x, (float)i0.y, (float)i0.z, (float)i0.w} * s0, v1 = (f32x4){(float)i1.x, (float)i1.y, (float)i1.z, (float)i1.w} * s1;
                v4u w; w.x = pk2(v0[0], v0[1]); w.y = pk2(v0[2], v0[3]); w.z = pk2(v1[0], v1[1]); w.w = pk2(v1[2], v1[3]);
                *(GAS v4u*)(Q + (size_t)row * D + col) = w;
            }
        }
    }
};

__device__ __forceinline__ void s5_tables(Frame& F, int g, const int part, const int nparts, const int nrep_c = 1, const int nrep_w = 1) {
    LAS float* APW = (LAS float*)F.lds;
    LAS float* BB = APW + 2 * 33 * 64 * 2;
    LAS float* CC = BB + 2 * 64 * 16 * 2;
    LAS float* KC = CC + 2 * 16 * 64 * 2;
    GAS const float* a_re = F.inp(9); GAS const float* a_im = F.inp(10); GAS const float* log_dt = F.inp(11);
    GAS const float* b_re = F.inp(12); GAS const float* b_im = F.inp(13); GAS const float* c_re = F.inp(14); GAS const float* c_im = F.inp(15);
    for (int rc = 0; rc < nrep_c; ++rc) {
    if (F.tid < 128) {
        const int p = F.tid & 63, dir = F.tid >> 6;
        const float dt = expf(log_dt[dir * 64 + g]);
        const float ar = a_re[(dir * 64 + g) * 64 + p], ai = a_im[(dir * 64 + g) * 64 + p];
        const float mag = expf(dt * ar); float sn, cs; sincosf(dt * ai, &sn, &cs);
        const float a1r = mag * cs, a1i = mag * sn;
        float zr = 1.0f, zi = 0.0f;
        for (int j = 0; j <= 32; ++j) { APW[((dir * 33 + j) * 64 + p) * 2] = zr; APW[((dir * 33 + j) * 64 + p) * 2 + 1] = zi; const float nr = zr * a1r - zi * a1i, ni = zr * a1i + zi * a1r; zr = nr; zi = ni; }
    }
    __syncthreads();
    for (int idx = F.tid; idx < 2 * 64 * 16; idx += 512) {
        const int hp = idx & 15, p = (idx >> 4) & 63, dir = idx >> 10;
        const float ar = a_re[(dir * 64 + g) * 64 + p], ai = a_im[(dir * 64 + g) * 64 + p];
        const float a1r = APW[((dir * 33 + 1) * 64 + p) * 2], a1i = APW[((dir * 33 + 1) * 64 + p) * 2 + 1];
        const float nr = a1r - 1.0f, ni = a1i, den = ar * ar + ai * ai;
        const float fre = (nr * ar + ni * ai) / den, fim = (ni * ar - nr * ai) / den;
        const float br = b_re[((size_t)(dir * 64 + g) * 64 + p) * 16 + hp], bi = b_im[((size_t)(dir * 64 + g) * 64 + p) * 16 + hp];
        BB[idx * 2] = fre * br - fim * bi; BB[idx * 2 + 1] = fre * bi + fim * br;
    }
    for (int idx = F.tid; idx < 2 * 16 * 64; idx += 512) {
        const int p = idx & 63, h = (idx >> 6) & 15, dir = idx >> 10;
        CC[idx * 2] = c_re[((size_t)(dir * 64 + g) * 16 + h) * 64 + p]; CC[idx * 2 + 1] = c_im[((size_t)(dir * 64 + g) * 16 + h) * 64 + p];
    }
    __syncthreads();
    {
        const int hp = F.tid & 15, h = (F.tid >> 4) & 15, dir = F.tid >> 8;
        LAS float* kc = KC + ((dir * 16 + h) * 16 + hp) * 33;
#pragma unroll 1
        for (int pb = 0; pb < 64; pb += 16) {
            float zr[16], zi[16];
#pragma unroll
            for (int q = 0; q < 16; ++q) { const int p = pb + q;
                const float cr = CC[((dir * 16 + h) * 64 + p) * 2], ci = CC[((dir * 16 + h) * 64 + p) * 2 + 1];
                const float br = BB[((dir * 64 + p) * 16 + hp) * 2], bi = BB[((dir * 64 + p) * 16 + hp) * 2 + 1];
                zr[q] = cr * br - ci * bi; zi[q] = cr * bi + ci * br; }
            const int jmax = nparts == 4 ? (dir == 0 ? 8 * part + 8 : 32 - 8 * part) : 32;
#pragma unroll 1
            for (int j = 0; j < jmax; ++j) {
                const LAS f32x4* ap = (const LAS f32x4*)(APW + ((dir * 33 + j) * 64 + pb) * 2);
                float sr = 0.f;
#pragma unroll
                for (int q2 = 0; q2 < 8; ++q2) { const f32x4 a = ap[q2]; sr += a.x * zr[2 * q2] - a.y * zi[2 * q2] + a.z * zr[2 * q2 + 1] - a.w * zi[2 * q2 + 1]; }
                kc[j] = (pb == 0) ? sr : kc[j] + sr;
            }
        }
    }
    __syncthreads();
    }
    for (int rw = 0; rw < nrep_w; ++rw) {
    GAS bf16* TB = (GAS bf16*)(F.ws + WS_D) + (size_t)g * 512 * 768;
    for (int ck = (512 / nparts) * part * 96 + F.tid; ck < (512 / nparts) * (part + 1) * 96; ck += 512) {
        const int n = ck / 96, kc = ck % 96, k0 = kc * 8, t = n >> 4, h = n & 15;
        float v[8];
        if (k0 < 512) {
            const int s = k0 >> 4, h0 = k0 & 15;
#pragma unroll
            for (int i = 0; i < 8; ++i) { float x = 0.f;
                if (s <= t) x += KC[((0 * 16 + h) * 16 + h0 + i) * 33 + (t - s)];
                if (s >= t) x += KC[((1 * 16 + h) * 16 + h0 + i) * 33 + (s - t)];
                v[i] = x; }
        } else {
            const int part = (k0 - 512) >> 6, p0 = (k0 - 512) & 63, dir = part >> 1, pw = dir == 0 ? t + 1 : 32 - t;
#pragma unroll
            for (int i2 = 0; i2 < 4; ++i2) { const int p = p0 + 2 * i2;
                const f32x4 c2 = *(const LAS f32x4*)(CC + ((dir * 16 + h) * 64 + p) * 2), a2 = *(const LAS f32x4*)(APW + ((dir * 33 + pw) * 64 + p) * 2);
                v[2 * i2] = (part & 1) ? -(c2.x * a2.y + c2.y * a2.x) : (c2.x * a2.x - c2.y * a2.y);
                v[2 * i2 + 1] = (part & 1) ? -(c2.z * a2.w + c2.w * a2.z) : (c2.z * a2.z - c2.w * a2.w); }
        }
        v4u w; w.x = pk2(v[0], v[1]); w.y = pk2(v[2], v[3]); w.z = pk2(v[4], v[5]); w.w = pk2(v[6], v[7]);
        *(GAS v4u*)(TB + (size_t)n * 768 + k0) = w;
    }
    GAS bf16* EB = (GAS bf16*)(F.ws + WS_E) + (size_t)g * 256 * 512;
    for (int ck = (256 / nparts) * part * 64 + F.tid; ck < (256 / nparts) * (part + 1) * 64; ck += 512) {
        const int n = ck >> 6, kc = ck & 63, k0 = kc * 8, s = k0 >> 4, h0 = k0 & 15;
        const int part = n >> 6, p = n & 63, dir = part >> 1, pw = dir == 0 ? 31 - s : s;
        const float pr = APW[((dir * 33 + pw) * 64 + p) * 2], pi = APW[((dir * 33 + pw) * 64 + p) * 2 + 1];
        float v[8];
#pragma unroll
        for (int i = 0; i < 8; ++i) { const float br = BB[((dir * 64 + p) * 16 + h0 + i) * 2], bi = BB[((dir * 64 + p) * 16 + h0 + i) * 2 + 1];
            v[i] = (part & 1) ? (pr * bi + pi * br) : (pr * br - pi * bi); }
        v4u w; w.x = pk2(v[0], v[1]); w.y = pk2(v[2], v[3]); w.z = pk2(v[4], v[5]); w.w = pk2(v[6], v[7]);
        *(GAS v4u*)(EB + (size_t)n * 512 + k0) = w;
    }
    }
    __syncthreads();
}
__device__ __forceinline__ void mod_partials(Frame& F, int blk, int nblk) {
    LAS float* SV = (LAS float*)F.lds;
    GAS const float* c = F.inp(1); GAS const float* cctx = F.inp(3); GAS const float* W = F.inp(4);
    for (int idx = F.tid; idx < 5 * D; idx += 512) { const int r = idx >> 11, k = idx & 2047; const float v = r < 4 ? c[r * D + k] : cctx[k]; SV[idx] = v * sigmoidf_(v); }
    __syncthreads();
    GAS float* MODP = (GAS float*)(F.ws + WS_MODP);
    for (int item = blk * NWAVES + F.wave; item < 48 * KS_MOD; item += nblk * NWAVES) {
        const int cg = item % 48, ks = item / 48, col = cg * 256 + F.lane * 4, kbeg = ks * (D / KS_MOD);
        f32x4 a0 = {0.f, 0.f, 0.f, 0.f}, a1 = a0, a2 = a0, a3 = a0, a4 = a0;
        for (int k0 = 0; k0 < D / KS_MOD; k0 += 8) {
            f32x4 w[8];
#pragma unroll
            for (int kk = 0; kk < 8; ++kk) w[kk] = *(GAS const f32x4*)(W + (size_t)(kbeg + k0 + kk) * NMOD + col);
#pragma unroll
            for (int kk = 0; kk < 8; ++kk) { const int k = kbeg + k0 + kk;
                a0 += SV[k] * w[kk]; a1 += SV[D + k] * w[kk]; a2 += SV[2 * D + k] * w[kk]; a3 += SV[3 * D + k] * w[kk]; a4 += SV[4 * D + k] * w[kk]; }
        }
        GAS float* o = MODP + (size_t)ks * 5 * NMOD + col;
        *(GAS f32x4*)(o) = a0; *(GAS f32x4*)(o + NMOD) = a1; *(GAS f32x4*)(o + 2 * NMOD) = a2; *(GAS f32x4*)(o + 3 * NMOD) = a3; *(GAS f32x4*)(o + 4 * NMOD) = a4;
    }
    __syncthreads();
}
__device__ __forceinline__ void mod_full(Frame& F, int blk) {
    LAS float* SV = (LAS float*)F.lds;
    LAS float* PR = SV + 5 * D;
    GAS const float* c = F.inp(1); GAS const float* cctx = F.inp(3); GAS const float* W = F.inp(4);
    for (int idx = F.tid; idx < 5 * D; idx += 512) { const int r = idx >> 11, k = idx & 2047; const float v = r < 4 ? c[r * D + k] : cctx[k]; SV[idx] = v * sigmoidf_(v); }
    __syncthreads();
    const int l = F.lane, r2 = l >= 24 ? 1 : 0, cl = l - 24 * r2;
    if (l < 48) {
        f32x4 a0 = {0.f, 0.f, 0.f, 0.f}, a1 = a0, a2 = a0, a3 = a0, a4 = a0;
        GAS const float* wp = W + (size_t)(F.wave * 256 + r2) * NMOD + blk * 96 + cl * 4;
        for (int k0 = 0; k0 < 256; k0 += 32) {
            f32x4 w[16];
#pragma unroll
            for (int kk = 0; kk < 16; ++kk) w[kk] = *(GAS const f32x4*)(wp + (size_t)(k0 + 2 * kk) * NMOD);
#pragma unroll
            for (int kk = 0; kk < 16; ++kk) { const int k = F.wave * 256 + k0 + 2 * kk + r2;
                a0 += SV[k] * w[kk]; a1 += SV[D + k] * w[kk]; a2 += SV[2 * D + k] * w[kk]; a3 += SV[3 * D + k] * w[kk]; a4 += SV[4 * D + k] * w[kk]; }
        }
        LAS f32x4* pr = (LAS f32x4*)(PR + (F.wave * 48 + l) * 20);
        pr[0] = a0; pr[1] = a1; pr[2] = a2; pr[3] = a3; pr[4] = a4;
    }
    __syncthreads();
    if (F.tid < 480) { const int r = F.tid / 96, cc = F.tid % 96, cq = cc >> 2, i = cc & 3;
        float sacc = F.inp(5)[blk * 96 + cc];
#pragma unroll
        for (int w = 0; w < 8; ++w) sacc += PR[(w * 48 + cq) * 20 + r * 4 + i] + PR[(w * 48 + 24 + cq) * 20 + r * 4 + i];
        ((GAS float*)(F.ws + WS_MOD))[(size_t)r * NMOD + blk * 96 + cc] = sacc; }
    __syncthreads();
}
__device__ __forceinline__ void transpose_item(GAS const float* W, int K, int N, GAS bf16* WT, LAS float* scr, int item, int lane) {
    const int nblk = N / 32, kb = item / nblk, nb = item % nblk, k0 = 64 * kb, n0 = 32 * nb;
    float tv[32];
#pragma unroll
    for (int i = 0; i < 32; ++i) { const int kk = 2 * i + (lane >> 5); tv[i] = W[(size_t)(k0 + kk) * N + n0 + (lane & 31)]; }
#pragma unroll
    for (int i = 0; i < 32; ++i) { const int kk = 2 * i + (lane >> 5); scr[kk * 33 + (lane & 31)] = tv[i]; }
    LDS_WAIT(); asm volatile("" ::: "memory");
    const int c = lane & 7;
#pragma unroll
    for (int j = 0; j < 4; ++j) { const int n = (lane >> 3) + 8 * j; const LAS float* s = scr + (8 * c) * 33 + n;
        v4u o; o.x = pk2(s[0 * 33], s[1 * 33]); o.y = pk2(s[2 * 33], s[3 * 33]); o.z = pk2(s[4 * 33], s[5 * 33]); o.w = pk2(s[6 * 33], s[7 * 33]);
        *(GAS v4u*)(WT + (size_t)(n0 + n) * K + k0 + 8 * c) = o; }
    LDS_WAIT(); asm volatile("" ::: "memory");
}

__device__ __forceinline__ void win_amax_partials(Frame& F, GAS const float* W, const int N, GAS float* WAM, const int gw, const int ngw) {
    const int ncg = N / 256;
    for (int item = gw; item < ncg * 16; item += ngw) {
        const int cg = item % ncg, ks = item / ncg, col = cg * 256 + F.lane * 4;
        f32x4 am = {0.f, 0.f, 0.f, 0.f};
        for (int k0 = 0; k0 < 128; k0 += 8) {
            f32x4 w[8];
#pragma unroll
            for (int kk = 0; kk < 8; ++kk) w[kk] = *(GAS const f32x4*)(W + (size_t)(ks * 128 + k0 + kk) * N + col);
#pragma unroll
            for (int kk = 0; kk < 8; ++kk) { am.x = fmaxf(am.x, fabsf(w[kk].x)); am.y = fmaxf(am.y, fabsf(w[kk].y)); am.z = fmaxf(am.z, fabsf(w[kk].z)); am.w = fmaxf(am.w, fabsf(w[kk].w)); }
        }
        *(GAS f32x4*)(WAM + (size_t)ks * N + col) = am;
    }
}
__device__ __forceinline__ void win_transpose_q8(Frame& F, GAS const float* W, const int N, GAS const float* WAM, GAS unsigned char* WT, GAS float* WSC, const int gw, const int ngw) {
    LAS float* scr = (LAS float*)(F.lds + F.wave * 16384);
    const int lane = F.lane;
    for (int item = gw; item < (D / 64) * (N / 32); item += ngw) {
        const int nblk = N / 32, kb = item / nblk, nb = item % nblk, k0 = 64 * kb, n0 = 32 * nb;
        float tv[32];
#pragma unroll
        for (int i = 0; i < 32; ++i) { const int kk = 2 * i + (lane >> 5); tv[i] = W[(size_t)(k0 + kk) * N + n0 + (lane & 31)]; }
        const int n = lane >> 1, half = lane & 1;
        float am = 0.f;
#pragma unroll
        for (int ks = 0; ks < 16; ++ks) am = fmaxf(am, WAM[(size_t)ks * N + n0 + n]);
#pragma unroll
        for (int i = 0; i < 32; ++i) { const int kk = 2 * i + (lane >> 5); scr[kk * 33 + (lane & 31)] = tv[i]; }
        LDS_WAIT(); asm volatile("" ::: "memory");
        const float inv = am > 0.f ? 127.0f / am : 0.f;
        if (kb == 0 && half == 0) WSC[n0 + n] = am > 0.f ? am * (1.0f / 127.0f) : 0.f;
        unsigned wq[8];
#pragma unroll
        for (int d = 0; d < 8; ++d) { const LAS float* sp = scr + (32 * half + 4 * d) * 33 + n;
            const int q0 = __float2int_rn(sp[0] * inv), q1 = __float2int_rn(sp[33] * inv), q2 = __float2int_rn(sp[66] * inv), q3 = __float2int_rn(sp[99] * inv);
            wq[d] = (unsigned)((q0 & 0xff) | ((q1 & 0xff) << 8) | ((q2 & 0xff) << 16) | ((q3 & 0xff) << 24)); }
        GAS unsigned char* dp = WT + (size_t)(n0 + n) * D + k0 + 32 * half;
        *(GAS v4u*)dp = (v4u){wq[0], wq[1], wq[2], wq[3]}; *(GAS v4u*)(dp + 16) = (v4u){wq[4], wq[5], wq[6], wq[7]};
        LDS_WAIT(); asm volatile("" ::: "memory");
    }
}
__device__ __forceinline__ void weight_transposes(Frame& F, const int gw, const int ngw) {
    LAS float* scr = (LAS float*)(F.lds + F.wave * 16384);
    constexpr int I_IN = (D / 64) * (INW / 32), I_GLU = (1024 / 64) * (1024 / 32), I_POOL1 = (256 / 64) * (256 / 32), I_PA = (1024 / 64) * (D / 32), I_WO = (D / 64) * (D / 32);
    constexpr int NITEMS = I_GLU + 4 * I_POOL1 + 2 * I_PA + 2 * I_WO;
    for (int it = gw; it < NITEMS; it += ngw) {
        int r = it;
        if (r < I_GLU) { transpose_item(F.inp(17), 1024, 1024, (GAS bf16*)(F.ws + WS_WGLU), scr, r, F.lane); continue; } r -= I_GLU;
        if (r < 4 * I_POOL1) { const int grp = r / I_POOL1; transpose_item(F.inp(19) + (size_t)grp * 65536, 256, 256, (GAS bf16*)(F.ws + WS_WPOOL) + (size_t)grp * 65536, scr, r % I_POOL1, F.lane); continue; } r -= 4 * I_POOL1;
        if (r < I_PA) { transpose_item(F.inp(21), 1024, D, (GAS bf16*)(F.ws + WS_PROJA), scr, r, F.lane); continue; } r -= I_PA;
        if (r < I_PA) { transpose_item(F.inp(22), 1024, D, (GAS bf16*)(F.ws + WS_PROJB), scr, r, F.lane); continue; } r -= I_PA;
        if (r < I_WO) { transpose_item(F.inp(23), D, D, (GAS bf16*)(F.ws + WS_WOUT), scr, r, F.lane); continue; } r -= I_WO;
        if (!Q_I8) transpose_item(F.inp(24), D, D, (GAS bf16*)(F.ws + WS_WQ), scr, r, F.lane);
    }
}
__device__ __forceinline__ void p1_convert(Frame& F) {
    for (int e = F.gw * 64 + F.lane; e < 5 * NMOD; e += F.NGW * 64) { const int col = e % NMOD; GAS const float* MODP = (GAS const float*)(F.ws + WS_MODP); float s = F.inp(5)[col];
        for (int ks = 0; ks < KS_MOD; ++ks) s += MODP[(size_t)ks * 5 * NMOD + e];
        ((GAS float*)(F.ws + WS_MOD))[e] = s; }
    for (int e = F.gw * 64 + F.lane; e < 2 * 16384; e += F.NGW * 64) { const float v = e < 16384 ? F.inp(25)[e] : F.inp(26)[e - 16384]; ((GAS bf16*)(F.ws + WS_K12))[e] = (bf16)f2bf(v); }
}
template <bool Q8, int NR, bool BF = true, int DELTA = 0>
__device__ __forceinline__ void modnorm_rows(int lane, GAS const float* const (&xrow)[NR], GAS const bf16* const (&drow)[NR], GAS const float* nw, GAS const float* const (&shift)[NR], GAS const float* const (&scale)[NR], GAS bf16* const (&orow)[NR], GAS unsigned char* const (&qrow)[NR], GAS float* const (&qscl)[NR]) {
    f32x4 v[NR][8]; float rstd[NR];
#pragma unroll
    for (int r = 0; r < NR; ++r)
#pragma unroll
        for (int j = 0; j < 8; ++j) {
            if (DELTA == 2) { const v2u dw = *(GAS const v2u*)(drow[r] + j * 256 + lane * 4); v[r][j] = (f32x4){bflo(dw.x), bfhi(dw.x), bflo(dw.y), bfhi(dw.y)}; continue; }
            v[r][j] = *(GAS const f32x4*)(xrow[r] + j * 256 + lane * 4);
            if (DELTA == 1) { const v2u dw = *(GAS const v2u*)(drow[r] + j * 256 + lane * 4); v[r][j] += (f32x4){bflo(dw.x), bfhi(dw.x), bflo(dw.y), bfhi(dw.y)}; } }
#pragma unroll
    for (int r = 0; r < NR; ++r) { float s = 0.f;
#pragma unroll
        for (int j = 0; j < 8; ++j) s += (v[r][j].x * v[r][j].x + v[r][j].y * v[r][j].y) + (v[r][j].z * v[r][j].z + v[r][j].w * v[r][j].w);
        rstd[r] = 1.0f / sqrtf(wave_sum(s) * (1.0f / D) + EPS); }
#pragma unroll
    for (int r = 0; r < NR; ++r) {
        float am = 0.f;
#pragma unroll
        for (int j = 0; j < 8; ++j) { const int col = j * 256 + lane * 4;
            const f32x4 w = *(GAS const f32x4*)(nw + col), sc = *(GAS const f32x4*)(scale[r] + col), sh = *(GAS const f32x4*)(shift[r] + col);
            const f32x4 o = (v[r][j] * rstd[r]) * w * (sc + 1.0f) + sh;
            if (BF) { v2u pw; pw.x = pk2(o.x, o.y); pw.y = pk2(o.z, o.w); *(GAS v2u*)(orow[r] + col) = pw; }
            if (Q8) { v[r][j] = o; am = fmaxf(am, fmaxf(fmaxf(fabsf(o.x), fabsf(o.y)), fmaxf(fabsf(o.z), fabsf(o.w)))); } }
        if (Q8) {
            am = wave_max(am);
            const float inv = am > 0.f ? 127.0f / am : 0.f;
            if (lane == 0) *qscl[r] = am > 0.f ? am * (1.0f / 127.0f) : 0.f;
#pragma unroll
            for (int j = 0; j < 8; ++j) { const int q0 = __float2int_rn(v[r][j].x * inv), q1 = __float2int_rn(v[r][j].y * inv), q2 = __float2int_rn(v[r][j].z * inv), q3 = __float2int_rn(v[r][j].w * inv);
                *(GAS int*)(qrow[r] + j * 256 + lane * 4) = (q0 & 0xff) | ((q1 & 0xff) << 8) | ((q2 & 0xff) << 16) | ((q3 & 0xff) << 24); }
        }
    }
}
__device__ __forceinline__ void s5_scan(Frame& F, int blk) {
    const int gt = blk * 512 + F.tid;
    const int p = gt & 63, dir = (gt >> 6) & 1, g = (gt >> 7) & 63, b = gt >> 13;
    const float dt = expf(F.inp(11)[dir * 64 + g]);
    const float ar = F.inp(9)[(dir * 64 + g) * 64 + p], ai = F.inp(10)[(dir * 64 + g) * 64 + p];
    const float mag = expf((float)TCH * dt * ar); float sn, cs; sincosf((float)TCH * dt * ai, &sn, &cs);
    const float atr = mag * cs, ati = mag * sn;
    GAS const float* HL = (GAS const float*)(F.ws + WS_F) + (size_t)g * CROWS * 256 + dir * 128 + p;
    GAS bf16* UH = (GAS bf16*)(F.ws + WS_B) + (size_t)g * CROWS * USLD + 512 + dir * 128 + p;
    float hr = 0.f, hi = 0.f;
    {
        float lr[8], li[8];
#pragma unroll
        for (int q = 0; q < 8; ++q) { const int row = 512 + b * NCHC + (dir ? NCHC - 1 - q : q); lr[q] = HL[(size_t)row * 256]; li[q] = HL[(size_t)row * 256 + 64]; }
#pragma unroll
        for (int q = 0; q < 8; ++q) { const float nr = atr * hr - ati * hi + lr[q], ni = atr * hi + ati * hr + li[q]; hr = nr; hi = ni; }
        if (DIAG == 11) { hr = 0.f; hi = 0.f; }
    }
#pragma unroll 1
    for (int i0 = 0; i0 < NCHL; i0 += 32) {
        float lr[32], li[32];
#pragma unroll
        for (int q = 0; q < 32; ++q) { const int row = b * NCHL + (dir ? NCHL - 1 - (i0 + q) : (i0 + q)); lr[q] = HL[(size_t)row * 256]; li[q] = HL[(size_t)row * 256 + 64]; }
#pragma unroll
        for (int q = 0; q < 32; ++q) { const int row = b * NCHL + (dir ? NCHL - 1 - (i0 + q) : (i0 + q));
            UH[(size_t)row * USLD] = (bf16)f2bf(hr); UH[(size_t)row * USLD + 64] = (bf16)f2bf(hi);
            const float nr = atr * hr - ati * hi + lr[q], ni = atr * hi + ati * hr + li[q]; hr = nr; hi = ni; }
    }
}

constexpr size_t WS_YN = WS_END;
__device__ __forceinline__ void s5_naive(Frame& F) {
    GAS const bf16* US = (GAS const bf16*)(F.ws + WS_B); GAS float* YN = (DIAG == 10 || DIAG == 11) ? F.out : (GAS float*)(F.ws + WS_YN);
    const int p = F.lane;
    for (int item = F.gw; item < NB * S5G; item += F.NGW) {
        const int b = item >> 6, g = item & 63;
        for (int dir = 0; dir < 2; ++dir) {
            const float dt = expf(F.inp(11)[dir * 64 + g]);
            const float ar = F.inp(9)[(dir * 64 + g) * 64 + p], ai = F.inp(10)[(dir * 64 + g) * 64 + p];
            const float mag = expf(dt * ar); float sn, cs; sincosf(dt * ai, &sn, &cs);
            const float abr = mag * cs, abi = mag * sn;
            const float nr = abr - 1.0f, ni = abi, den = ar * ar + ai * ai;
            const float fre = (nr * ar + ni * ai) / den, fim = (ni * ar - nr * ai) / den;
            float bbr[16], bbi[16], ccr[16], cci[16];
#pragma unroll
            for (int h = 0; h < 16; ++h) {
                const float br = F.inp(12)[((size_t)(dir * 64 + g) * 64 + p) * 16 + h], bi = F.inp(13)[((size_t)(dir * 64 + g) * 64 + p) * 16 + h];
                bbr[h] = fre * br - fim * bi; bbi[h] = fre * bi + fim * br;
                ccr[h] = F.inp(14)[((size_t)(dir * 64 + g) * 16 + h) * 64 + p]; cci[h] = F.inp(15)[((size_t)(dir * 64 + g) * 16 + h) * 64 + p];
            }
            float hr = 0.f, hi = 0.f;
            for (int step = 0; step < CTXL + SEQ; ++step) {
                const bool isctx = step < CTXL;
                const int tt = isctx ? (dir ? CTXL - 1 - step : step) : (dir ? SEQ - 1 - (step - CTXL) : (step - CTXL));
                const int crow = isctx ? 512 + b * NCHC + (tt >> 5) : b * NCHL + (tt >> 5);
                GAS const bf16* up = US + ((size_t)g * CROWS + crow) * USLD + (tt & 31) * 16;
                const v4u u0 = *(GAS const v4u*)up, u1 = *(GAS const v4u*)(up + 8);
                float uu[16];
                uu[0] = bflo(u0.x); uu[1] = bfhi(u0.x); uu[2] = bflo(u0.y); uu[3] = bfhi(u0.y); uu[4] = bflo(u0.z); uu[5] = bfhi(u0.z); uu[6] = bflo(u0.w); uu[7] = bfhi(u0.w);
                uu[8] = bflo(u1.x); uu[9] = bfhi(u1.x); uu[10] = bflo(u1.y); uu[11] = bfhi(u1.y); uu[12] = bflo(u1.z); uu[13] = bfhi(u1.z); uu[14] = bflo(u1.w); uu[15] = bfhi(u1.w);
                float br = 0.f, bi = 0.f;
#pragma unroll
                for (int h = 0; h < 16; ++h) { br += bbr[h] * uu[h]; bi += bbi[h] * uu[h]; }
                const float nhr = abr * hr - abi * hi + br, nhi = abr * hi + abi * hr + bi; hr = nhr; hi = nhi;
                if (!isctx) {
                    float yv = 0.f;
#pragma unroll
                    for (int h = 0; h < 16; ++h) { const float part = wave_sum(ccr[h] * hr - cci[h] * hi); yv = (p == h) ? part : yv; }
                    if (p < 16) { GAS float* yp = YN + ((size_t)b * SEQ + tt) * S5W + g * 16 + p; *yp = (dir == 0) ? yv : (*yp + yv); }
                }
            }
        }
    }
}
template <int W> __device__ __forceinline__ void pool_seg(GAS const bf16* zp, GAS bf16* pp) {
    float v[64];
#pragma unroll
    for (int i = 0; i < 64; ++i) v[i] = __builtin_bit_cast(float, (unsigned)zp[(size_t)i * 1024] << 16);
#pragma unroll
    for (int pos = 0; pos < 64; ++pos) {
        const int lo = pos - W / 2 < 0 ? 0 : pos - W / 2, hi = pos + W / 2 - 1 > 63 ? 63 : pos + W / 2 - 1;
        float s = 0.f;
#pragma unroll
        for (int j = lo; j <= hi; ++j) s += v[j];
        pp[(size_t)pos * 1024] = (bf16)f2bf(s * (1.0f / (float)(hi - lo + 1)) - v[pos]);
    }
}
__device__ __forceinline__ void pool_prep(Frame& F, int blk, int nblk) {
    GAS const bf16* ZP = (GAS const bf16*)(F.ws + WS_G); GAS bf16* PP = (GAS bf16*)(F.ws + WS_C);
    for (int it = blk * NWAVES + F.wave; it < 256 * 16; it += nblk * NWAVES) {
        const int seg = it >> 4, cb = it & 15, ch = cb * 64 + F.lane, grp = cb >> 2;
        GAS const bf16* zp = ZP + (size_t)seg * 64 * 1024 + ch; GAS bf16* pp = PP + (size_t)seg * 64 * 1024 + ch;
        if (grp == 0) pool_seg<2>(zp, pp); else if (grp == 1) pool_seg<4>(zp, pp); else if (grp == 2) pool_seg<8>(zp, pp); else pool_seg<16>(zp, pp);
    }
}
__device__ __forceinline__ void convert_table(Frame& F, GAS const float* src, GAS bf16* dst, size_t n) {
    for (size_t i = ((size_t)F.gw * 64 + F.lane) * 8; i < n; i += (size_t)F.NGW * 64 * 8) {
        const f32x4 a = *(GAS const f32x4*)(src + i), b = *(GAS const f32x4*)(src + i + 4);
        v4u w; w.x = pk2(a.x, a.y); w.y = pk2(a.z, a.w); w.z = pk2(b.x, b.y); w.w = pk2(b.z, b.w);
        *(GAS v4u*)(dst + i) = w;
    }
}

template <int N> __device__ __forceinline__ void bitonic_merge_desc(float (&a)[N]) {
#pragma unroll
    for (int j = N >> 1; j > 0; j >>= 1)
#pragma unroll
        for (int i = 0; i < N; ++i) { const int l = i ^ j; if (l > i) { const float hi = fmaxf(a[i], a[l]), lo = fminf(a[i], a[l]); a[i] = hi; a[l] = lo; } }
}
template <int N> __device__ __forceinline__ void bitonic_sort_desc(float (&a)[N]) {
#pragma unroll
    for (int k = 2; k <= N; k <<= 1)
#pragma unroll
        for (int j = k >> 1; j > 0; j >>= 1)
#pragma unroll
            for (int i = 0; i < N; ++i) { const int l = i ^ j; if (l > i) { const bool desc = ((i & k) == 0) || (k == N); const float hi = fmaxf(a[i], a[l]), lo = fminf(a[i], a[l]); a[i] = desc ? hi : lo; a[l] = desc ? lo : hi; } }
}
__device__ __forceinline__ void top16_merge(float (&x)[16], const float (&y)[16]) {
#pragma unroll
    for (int i = 0; i < 16; ++i) x[i] = fmaxf(x[i], y[15 - i]);
    bitonic_merge_desc<16>(x);
}
constexpr int KT_STRIDE = 272;
constexpr int KT_BYTES = 2 * 128 * KT_STRIDE;
constexpr int EX_STRIDE = 33;
__device__ __forceinline__ void peer_topk(Frame& F) {
    { GAS const bf16* K12 = (GAS const bf16*)(F.ws + WS_K12);
      for (int c = F.tid; c < 2 * 128 * 16; c += 512) { const int row = c >> 4, ch = c & 15; *(LAS v4u*)(F.lds + row * KT_STRIDE + ch * 16) = *(GAS const v4u*)(K12 + (size_t)row * 128 + ch * 8); } }
    __syncthreads();
    LAS float* EX = (LAS float*)(F.lds + KT_BYTES + F.wave * (64 * EX_STRIDE * 4));
    GAS const bf16* Q = (GAS const bf16*)(F.ws + WS_A);
    GAS int* EID = (GAS int*)(F.ws + WS_EID); GAS float* GW = (GAS float*)(F.ws + WS_GW);
    const int fr = F.lane & 15, fq = F.lane >> 4;
    const float NEG = -3.0e38f;
    for (int item = F.gw; item < (M / 16) * 2; item += F.NGW) {
        const int tg = item >> 1, hq = item & 1;
        for (int hl = 0; hl < 4; ++hl) {
            const int head = hq * 4 + hl;
#pragma unroll
            for (int j = 0; j < 2; ++j) {
                bf16x8 qf[4];
#pragma unroll
                for (int ks = 0; ks < 4; ++ks) qf[ks] = *(GAS const bf16x8*)(Q + (size_t)(tg * 16 + fr) * D + head * 256 + j * 128 + ks * 32 + fq * 8);
                f32x4 acc[8];
#pragma unroll
                for (int n = 0; n < 8; ++n) { acc[n] = (f32x4){0.f, 0.f, 0.f, 0.f};
#pragma unroll
                    for (int ks = 0; ks < 4; ++ks) { const bf16x8 kf = *(const LAS bf16x8*)(F.lds + (j * 128 + n * 16 + fr) * KT_STRIDE + (ks * 32 + fq * 8) * 2);
                        acc[n] = __builtin_amdgcn_mfma_f32_16x16x32_bf16(kf, qf[ks], acc[n], 0, 0, 0); } }
                float sc[32];
#pragma unroll
                for (int n = 0; n < 8; ++n)
#pragma unroll
                    for (int i = 0; i < 4; ++i) { const float sv = acc[n][i]; sc[n * 4 + i] = __builtin_bit_cast(float, (__builtin_bit_cast(unsigned, sv) & ~127u) | (unsigned)(n * 16 + fq * 4 + i)); }
                float ta[16], tb[16];
#pragma unroll
                for (int e = 0; e < 16; ++e) { ta[e] = sc[e]; tb[e] = sc[16 + e]; }
                bitonic_sort_desc<16>(ta); bitonic_sort_desc<16>(tb); top16_merge(ta, tb);
#pragma unroll
                for (int e = 0; e < 16; ++e) tb[e] = __builtin_bit_cast(float, __builtin_amdgcn_ds_swizzle(__builtin_bit_cast(int, ta[e]), 0x401F));
                top16_merge(ta, tb);
#pragma unroll
                for (int e = 0; e < 16; ++e) tb[e] = shfl_idx(ta[e], F.lane ^ 32);
                top16_merge(ta, tb);
                if (fq == 0) {
#pragma unroll
                    for (int k = 0; k < 16; ++k) EX[(hl * 16 + fr) * EX_STRIDE + j * 16 + k] = ta[k];
                }
            }
        }
        LDS_WAIT(); asm volatile("" ::: "memory");
        {
            const int hl = F.lane >> 4, tok = tg * 16 + (F.lane & 15), head = hq * 4 + hl;
            float v1[16], v2[16];
#pragma unroll
            for (int k = 0; k < 16; ++k) { v1[k] = EX[F.lane * EX_STRIDE + k]; v2[k] = EX[F.lane * EX_STRIDE + 16 + k]; }
#define CANDV(a, b) __builtin_bit_cast(float, (__builtin_bit_cast(unsigned, __builtin_bit_cast(float, __builtin_bit_cast(unsigned, v1[a]) & ~127u) + __builtin_bit_cast(float, __builtin_bit_cast(unsigned, v2[b]) & ~127u)) & ~255u) | (unsigned)((a) * 16 + (b)))
            float top[16], l1[16], l2[16], l3[16];
#pragma unroll
            for (int b = 0; b < 16; ++b) top[b] = CANDV(0, b);
#pragma unroll
            for (int b = 0; b < 8; ++b) l1[b] = CANDV(1, b);
#pragma unroll
            for (int b = 0; b < 5; ++b) l1[8 + b] = CANDV(2, b);
#pragma unroll
            for (int b = 0; b < 3; ++b) l1[13 + b] = CANDV(4, b);
#pragma unroll
            for (int b = 0; b < 4; ++b) l2[b] = CANDV(3, b);
            l2[4] = CANDV(5, 0); l2[5] = CANDV(5, 1); l2[6] = CANDV(6, 0); l2[7] = CANDV(6, 1); l2[8] = CANDV(7, 0); l2[9] = CANDV(7, 1);
            l2[10] = CANDV(8, 0); l2[11] = CANDV(9, 0); l2[12] = CANDV(10, 0); l2[13] = CANDV(11, 0); l2[14] = CANDV(12, 0); l2[15] = CANDV(13, 0);
            { const float c14 = CANDV(14, 0), c15 = CANDV(15, 0); l3[0] = fmaxf(c14, c15); l3[1] = fminf(c14, c15); }
#pragma unroll
            for (int b = 2; b < 16; ++b) l3[b] = NEG;
#undef CANDV
            bitonic_sort_desc<16>(top); bitonic_sort_desc<16>(l1); bitonic_sort_desc<16>(l2);
            top16_merge(top, l1); top16_merge(l2, l3); top16_merge(top, l2);
            float es[16], sum = 0.f; const float m0 = __builtin_bit_cast(float, __builtin_bit_cast(unsigned, top[0]) & ~255u);
            int ids[16];
#pragma unroll
            for (int k = 0; k < 16; ++k) {
                const unsigned bits = __builtin_bit_cast(unsigned, top[k]); const int a = (bits >> 4) & 15, b = bits & 15;
                const unsigned w1 = __builtin_bit_cast(unsigned, EX[F.lane * EX_STRIDE + a]), w2 = __builtin_bit_cast(unsigned, EX[F.lane * EX_STRIDE + 16 + b]);
                ids[k] = (int)((w1 & 127u) * 128u + (w2 & 127u));
                es[k] = __expf(__builtin_bit_cast(float, bits & ~255u) - m0); sum += es[k];
            }
            const float inv = 1.0f / sum;
            GAS int* ep = EID + (size_t)tok * 128 + head * 16; GAS float* gp = GW + (size_t)tok * 128 + head * 16;
#pragma unroll
            for (int k4 = 0; k4 < 4; ++k4) {
                *(GAS i32x4*)(ep + k4 * 4) = (i32x4){ids[k4 * 4], ids[k4 * 4 + 1], ids[k4 * 4 + 2], ids[k4 * 4 + 3]};
                *(GAS f32x4*)(gp + k4 * 4) = (f32x4){es[k4 * 4] * inv, es[k4 * 4 + 1] * inv, es[k4 * 4 + 2] * inv, es[k4 * 4 + 3] * inv};
            }
        }
        LDS_WAIT(); asm volatile("" ::: "memory");
    }
    __syncthreads();
}
__device__ __forceinline__ float dot2u(unsigned a, unsigned b, float acc) {
    return __builtin_amdgcn_fdot2_f32_bf16(__builtin_bit_cast(bf16x2_t, a), __builtin_bit_cast(bf16x2_t, b), acc, false);
}
__device__ __forceinline__ float dot8(const v4u a, const v4u b, float acc) {
    const unsigned a0 = a.x, a1 = a.y, a2 = a.z, a3 = a.w, b0 = b.x, b1 = b.y, b2 = b.z, b3 = b.w;
    acc = dot2u(a0, b0, acc); acc = dot2u(a1, b1, acc); acc = dot2u(a2, b2, acc); acc = dot2u(a3, b3, acc);
    return acc;
}
__device__ __forceinline__ void peer_gather(Frame& F) {
    GAS const bf16* H2 = (GAS const bf16*)(F.ws + WS_C); GAS const bf16* UT = (GAS const bf16*)(F.ws + WS_D); GAS const bf16* VT = (GAS const bf16*)(F.ws + WS_B);
    GAS const int* EID = (GAS const int*)(F.ws + WS_EID); GAS const float* GW = (GAS const float*)(F.ws + WS_GW);
    GAS const float* MOD = (GAS const float*)(F.ws + WS_MOD); GAS const float* fw = F.inp(29);
    GAS float* X = F.out;
    const int lane = F.lane;
    for (int tok = F.gw; tok < M; tok += F.NGW) {
        const int b = tok >> 12;
        v4u hreg[4];
#pragma unroll
        for (int j = 0; j < 4; ++j) hreg[j] = *(GAS const v4u*)(H2 + (size_t)tok * D + j * 512 + lane * 8);
        const int e0 = EID[(size_t)tok * 128 + lane], e1 = EID[(size_t)tok * 128 + 64 + lane];
        const float g0 = GW[(size_t)tok * 128 + lane], g1 = GW[(size_t)tok * 128 + 64 + lane];
        float act0 = 0.f, act1 = 0.f;
#pragma unroll 1
        for (int eb = 0; eb < 128; eb += 4) {
            v4u ur[4][4];
#pragma unroll
            for (int q = 0; q < 4; ++q) { const int e = eb + q; const int id = shfl_idx_i(e < 64 ? e0 : e1, e & 63);
                GAS const bf16* up = UT + (size_t)id * D + lane * 8;
#pragma unroll
                for (int j = 0; j < 4; ++j) ur[q][j] = *(GAS const v4u*)(up + j * 512); }
#pragma unroll
            for (int q = 0; q < 4; ++q) { float pp = 0.f;
#pragma unroll
                for (int j = 0; j < 4; ++j) pp = dot8(ur[q][j], hreg[j], pp);
                pp = wave_sum(pp);
                const int e = eb + q; const float a = gelu_tanh(pp);
                if (e < 64) act0 = (lane == e) ? a : act0; else act1 = (lane == (e - 64)) ? a : act1; }
        }
        act0 *= g0; act1 *= g1;
        if (DIAG == 1) { act0 = 0.f; act1 = 0.f; }
        if (DIAG == 3) { act0 = g0; act1 = g1; }
        float o[32];
#pragma unroll
        for (int i = 0; i < 32; ++i) o[i] = 0.f;
#pragma unroll 1
        for (int eb = 0; eb < 128; eb += 4) {
            v4u vr[4][4]; float aa[4];
#pragma unroll
            for (int q = 0; q < 4; ++q) { const int e = eb + q; const int id = shfl_idx_i(e < 64 ? e0 : e1, e & 63); aa[q] = shfl_idx(e < 64 ? act0 : act1, e & 63);
                GAS const bf16* vp = VT + (size_t)id * D + lane * 8;
#pragma unroll
                for (int j = 0; j < 4; ++j) vr[q][j] = *(GAS const v4u*)(vp + j * 512); }
#pragma unroll
            for (int q = 0; q < 4; ++q)
#pragma unroll
                for (int j = 0; j < 4; ++j) { const v4u w = vr[q][j]; const float a = aa[q];
                    o[j * 8 + 0] += a * bflo(w.x); o[j * 8 + 1] += a * bfhi(w.x); o[j * 8 + 2] += a * bflo(w.y); o[j * 8 + 3] += a * bfhi(w.y);
                    o[j * 8 + 4] += a * bflo(w.z); o[j * 8 + 5] += a * bfhi(w.z); o[j * 8 + 6] += a * bflo(w.w); o[j * 8 + 7] += a * bfhi(w.w); }
        }
        GAS const float* g2 = MOD + (size_t)b * NMOD + 5 * D;
        float ss = 0.f;
#pragma unroll
        for (int j = 0; j < 4; ++j) { const int col = j * 512 + lane * 8;
            const f32x4 xa = *(GAS const f32x4*)(X + (size_t)tok * D + col), xb = *(GAS const f32x4*)(X + (size_t)tok * D + col + 4);
            const f32x4 ga = *(GAS const f32x4*)(g2 + col), gb = *(GAS const f32x4*)(g2 + col + 4);
            o[j * 8 + 0] = xa.x + ga.x * o[j * 8 + 0]; o[j * 8 + 1] = xa.y + ga.y * o[j * 8 + 1]; o[j * 8 + 2] = xa.z + ga.z * o[j * 8 + 2]; o[j * 8 + 3] = xa.w + ga.w * o[j * 8 + 3];
            o[j * 8 + 4] = xb.x + gb.x * o[j * 8 + 4]; o[j * 8 + 5] = xb.y + gb.y * o[j * 8 + 5]; o[j * 8 + 6] = xb.z + gb.z * o[j * 8 + 6]; o[j * 8 + 7] = xb.w + gb.w * o[j * 8 + 7];
#pragma unroll
            for (int i = 0; i < 8; ++i) ss += o[j * 8 + i] * o[j * 8 + i]; }
        const float rstd = 1.0f / sqrtf(wave_sum(ss) * (1.0f / D) + EPS);
#pragma unroll
        for (int j = 0; j < 4; ++j) { const int col = j * 512 + lane * 8;
            const f32x4 wa = *(GAS const f32x4*)(fw + col), wb = *(GAS const f32x4*)(fw + col + 4);
            *(GAS f32x4*)(X + (size_t)tok * D + col) = (f32x4){o[j * 8 + 0] * rstd * wa.x, o[j * 8 + 1] * rstd * wa.y, o[j * 8 + 2] * rstd * wa.z, o[j * 8 + 3] * rstd * wa.w};
            *(GAS f32x4*)(X + (size_t)tok * D + col + 4) = (f32x4){o[j * 8 + 4] * rstd * wb.x, o[j * 8 + 5] * rstd * wb.y, o[j * 8 + 6] * rstd * wb.z, o[j * 8 + 7] * rstd * wb.w}; }
    }
}


#define DPP_ADDF(v, ctrl) (v) += __builtin_bit_cast(float, __builtin_amdgcn_update_dpp(0, __builtin_bit_cast(int, (v)), (ctrl), 0xf, 0xf, false))
constexpr int PS_NS = 32, PS_SD = 64;
#define PS_LOAD_IDS(dst, b) do { _Pragma("unroll") for (int q = 0; q < 4; ++q) { const i32x4 t4 = *(const LAS i32x4*)(EIDT + g * 128 + (b) * 16 + q * 4); \
        dst[q * 4] = t4.x; dst[q * 4 + 1] = t4.y; dst[q * 4 + 2] = t4.z; dst[q * 4 + 3] = t4.w; } } while (0)
#define PS_ISSUE(rows, base, loff, ids) do { _Pragma("unroll") for (int i = 0; i < 16; ++i) rows[i] = *(GAS const v4u*)((base) + (((unsigned)ids[i] << 12) + (loff))); } while (0)
__device__ __forceinline__ void peer_sliced(Frame& F) {
    GAS const bf16* H2 = (GAS const bf16*)(F.ws + WS_C); GAS const char* UT = (GAS const char*)(F.ws + WS_D); GAS const char* VT = (GAS const char*)(F.ws + WS_B);
    GAS const int* EID = (GAS const int*)(F.ws + WS_EID); GAS const float* GW = (GAS const float*)(F.ws + WS_GW);
    GAS bf16* PO = (GAS bf16*)(F.ws + WS_A);
    GAS const float* MOD = (GAS const float*)(F.ws + WS_MOD); GAS const float* fw = F.inp(29);
    GAS float* X = F.out;
    const int lane = F.lane, g = lane >> 3, c = lane & 7;
    LAS int* EIDT = (LAS int*)(F.lds + F.wave * 8192);
    LAS float* ACTT = (LAS float*)(F.lds + F.wave * 8192 + 4096);
    for (int grp = blockIdx.x; grp < M / 64; grp += F.G) {
        const int tok0 = grp * 64 + F.wave * 8;
#pragma unroll
        for (int tt = 0; tt < 8; ++tt) { const unsigned eo = (unsigned)(tok0 + tt) * 128u + (unsigned)lane; EIDT[tt * 128 + lane] = EID[eo]; EIDT[tt * 128 + 64 + lane] = EID[eo + 64u]; }
        LDS_WAIT(); asm volatile("" ::: "memory");
        {
            float acc[16];
#pragma unroll
            for (int k = 0; k < 16; ++k) acc[k] = 0.f;
            v4u rA[16], rB[16]; int ids[16];
            const unsigned c16 = (unsigned)c * 16u;
            PS_LOAD_IDS(ids, 0); PS_ISSUE(rA, UT, c16, ids);
#pragma unroll 1
            for (int s = 0; s < PS_NS; ++s) {
                const v4u h2v = *(GAS const v4u*)((GAS const char*)H2 + ((unsigned)(tok0 + g) * (D * 2) + (unsigned)s * (PS_SD * 2) + c16));
                const unsigned ubs = c16 + (unsigned)s * (PS_SD * 2), ubn = c16 + (unsigned)(s + 1 < PS_NS ? s + 1 : s) * (PS_SD * 2);
#define PS_U_STEP(b, cur, nxt) do { \
                    PS_LOAD_IDS(ids, ((b) + 1) & 7); PS_ISSUE(nxt, UT, ((b) == 7 ? ubn : ubs), ids); \
                    asm volatile("" ::: "memory"); \
                    _Pragma("unroll") for (int i = 0; i < 16; ++i) { float p = dot8(cur[i], h2v, 0.f); \
                        DPP_ADDF(p, 0xB1); DPP_ADDF(p, 0x4E); DPP_ADDF(p, 0x141); \
                        acc[(b) * 2 + (i >> 3)] += (c == (i & 7)) ? p : 0.f; } \
                    asm volatile("" ::: "memory"); } while (0)
                PS_U_STEP(0, rA, rB); PS_U_STEP(1, rB, rA); PS_U_STEP(2, rA, rB); PS_U_STEP(3, rB, rA);
                PS_U_STEP(4, rA, rB); PS_U_STEP(5, rB, rA); PS_U_STEP(6, rA, rB); PS_U_STEP(7, rB, rA);
#undef PS_U_STEP
            }
            unsigned long long wsl = (unsigned long long)F.ws; asm volatile("" : "+s"(wsl));
            GAS const float* GWl = (GAS const float*)((GAS unsigned char*)wsl + WS_GW); const unsigned go = (unsigned)(tok0 + g) * 128u + (unsigned)c;
#pragma unroll
            for (int k = 0; k < 16; ++k) ACTT[g * 128 + 8 * k + c] = gelu_tanh(acc[k]) * GWl[go + 8u * k];
        }
        LDS_WAIT(); asm volatile("" ::: "memory");
        {
            v4u rA[16], rB[16]; int ids[16]; float av[16];
            const unsigned c16 = (unsigned)c * 16u;
            PS_LOAD_IDS(ids, 0); PS_ISSUE(rA, VT, c16, ids);
#pragma unroll 1
            for (int s = 0; s < PS_NS; ++s) {
                const unsigned vbs = c16 + (unsigned)s * (PS_SD * 2), vbn = c16 + (unsigned)(s + 1 < PS_NS ? s + 1 : s) * (PS_SD * 2);
                float o[8];
#pragma unroll
                for (int k = 0; k < 8; ++k) o[k] = 0.f;
#define PS_V_STEP(b, cur, nxt) do { \
                    PS_LOAD_IDS(ids, ((b) + 1) & 7); PS_ISSUE(nxt, VT, ((b) == 7 ? vbn : vbs), ids); \
                    _Pragma("unroll") for (int q = 0; q < 4; ++q) { const f32x4 a4 = *(const LAS f32x4*)(ACTT + g * 128 + (b) * 16 + q * 4); av[q * 4] = a4.x; av[q * 4 + 1] = a4.y; av[q * 4 + 2] = a4.z; av[q * 4 + 3] = a4.w; } \
                    asm volatile("" ::: "memory"); \
                    _Pragma("unroll") for (int i = 0; i < 16; ++i) { const v4u w = cur[i]; const float a = av[i]; \
                        o[0] += a * bflo(w.x); o[1] += a * bfhi(w.x); o[2] += a * bflo(w.y); o[3] += a * bfhi(w.y); o[4] += a * bflo(w.z); o[5] += a * bfhi(w.z); o[6] += a * bflo(w.w); o[7] += a * bfhi(w.w); } \
                    asm volatile("" ::: "memory"); } while (0)
                PS_V_STEP(0, rA, rB); PS_V_STEP(1, rB, rA); PS_V_STEP(2, rA, rB); PS_V_STEP(3, rB, rA);
                PS_V_STEP(4, rA, rB); PS_V_STEP(5, rB, rA); PS_V_STEP(6, rA, rB); PS_V_STEP(7, rB, rA);
#undef PS_V_STEP
                v4u w; w.x = pk2(o[0], o[1]); w.y = pk2(o[2], o[3]); w.z = pk2(o[4], o[5]); w.w = pk2(o[6], o[7]);
                *(GAS v4u*)((GAS char*)PO + ((unsigned)(tok0 + g) * (D * 2) + (unsigned)s * (PS_SD * 2) + c16)) = w;
            }
        }
        VM_WAIT();
#pragma unroll 1
        for (int tt = 0; tt < 8; ++tt) {
            const int tok = tok0 + tt; GAS const float* g2 = MOD + (size_t)(tok >> 12) * NMOD + 5 * D;
            float o[32]; float ss = 0.f;
#pragma unroll
            for (int j = 0; j < 4; ++j) { const int col = j * 512 + lane * 8;
                const f32x4 xa = *(GAS const f32x4*)(X + (size_t)tok * D + col), xb = *(GAS const f32x4*)(X + (size_t)tok * D + col + 4);
                const f32x4 ga = *(GAS const f32x4*)(g2 + col), gb = *(GAS const f32x4*)(g2 + col + 4);
                const v4u pw = *(GAS const v4u*)(PO + (size_t)tok * D + col);
                o[j * 8 + 0] = xa.x + ga.x * bflo(pw.x); o[j * 8 + 1] = xa.y + ga.y * bfhi(pw.x); o[j * 8 + 2] = xa.z + ga.z * bflo(pw.y); o[j * 8 + 3] = xa.w + ga.w * bfhi(pw.y);
                o[j * 8 + 4] = xb.x + gb.x * bflo(pw.z); o[j * 8 + 5] = xb.y + gb.y * bfhi(pw.z); o[j * 8 + 6] = xb.z + gb.z * bflo(pw.w); o[j * 8 + 7] = xb.w + gb.w * bfhi(pw.w);
#pragma unroll
                for (int i = 0; i < 8; ++i) ss += o[j * 8 + i] * o[j * 8 + i]; }
            const float rstd = 1.0f / sqrtf(wave_sum(ss) * (1.0f / D) + EPS);
#pragma unroll
            for (int j = 0; j < 4; ++j) { const int col = j * 512 + lane * 8;
                const f32x4 wa = *(GAS const f32x4*)(fw + col), wb = *(GAS const f32x4*)(fw + col + 4);
                *(GAS f32x4*)(X + (size_t)tok * D + col) = (f32x4){o[j * 8 + 0] * rstd * wa.x, o[j * 8 + 1] * rstd * wa.y, o[j * 8 + 2] * rstd * wa.z, o[j * 8 + 3] * rstd * wa.w};
                *(GAS f32x4*)(X + (size_t)tok * D + col + 4) = (f32x4){o[j * 8 + 4] * rstd * wb.x, o[j * 8 + 5] * rstd * wb.y, o[j * 8 + 6] * rstd * wb.z, o[j * 8 + 7] * rstd * wb.w}; }
        }
        LDS_WAIT(); asm volatile("" ::: "memory");
    }
}


#ifndef PEER_FP8
#define PEER_FP8 1
#endif
constexpr size_t WS_H8 = WS_G, WS_HSC = WS_I;
constexpr size_t WS_U8 = WS_T8, WS_V8 = WS_T8 + 32 * MiB, WS_USC = WS_K12 + 128 * 1024, WS_VSC = WS_K12 + 256 * 1024;
template <bool I8>
__device__ __forceinline__ void convert_rows4(Frame& F, GAS const float* src, GAS unsigned char* dst, GAS float* scl, const int r0) {
    constexpr int RB = 4; const float QM = I8 ? 127.0f : 448.0f;
    {
        f32x4 v[RB][8]; float am[RB];
#pragma unroll
        for (int q = 0; q < RB; ++q)
#pragma unroll
            for (int j = 0; j < 8; ++j) v[q][j] = *(GAS const f32x4*)(src + (size_t)(r0 + q) * D + j * 256 + F.lane * 4);
#pragma unroll
        for (int q = 0; q < RB; ++q) { float a = 0.f;
#pragma unroll
            for (int j = 0; j < 8; ++j) a = fmaxf(a, fmaxf(fmaxf(fabsf(v[q][j].x), fabsf(v[q][j].y)), fmaxf(fabsf(v[q][j].z), fabsf(v[q][j].w))));
            am[q] = wave_max(a); }
#pragma unroll
        for (int q = 0; q < RB; ++q) {
            const float inv = am[q] > 0.f ? QM / am[q] : 0.f;
            if (F.lane == 0) scl[r0 + q] = am[q] > 0.f ? am[q] * (1.0f / QM) : 0.f;
#pragma unroll
            for (int j = 0; j < 8; ++j) { int w;
                if (I8) { const int q0 = __float2int_rn(v[q][j].x * inv), q1 = __float2int_rn(v[q][j].y * inv), q2 = __float2int_rn(v[q][j].z * inv), q3 = __float2int_rn(v[q][j].w * inv);
                    w = (q0 & 0xff) | ((q1 & 0xff) << 8) | ((q2 & 0xff) << 16) | ((q3 & 0xff) << 24); }
                else { w = __builtin_amdgcn_cvt_pk_fp8_f32(v[q][j].x * inv, v[q][j].y * inv, 0, false); w = __builtin_amdgcn_cvt_pk_fp8_f32(v[q][j].z * inv, v[q][j].w * inv, w, true); }
                *(GAS int*)(dst + (size_t)(2 * j + (F.lane >> 5)) * ((size_t)PEER_E * 128) + (size_t)(r0 + q) * 128 + (F.lane & 31) * 4) = w; }
        }
    }
}
template <bool I8>
__device__ __forceinline__ void convert_table_q8(Frame& F, GAS const float* src, GAS unsigned char* dst, GAS float* scl, const int w0, const int nw) {
    for (int r0 = w0 * 4; r0 < PEER_E; r0 += nw * 4) convert_rows4<I8>(F, src, dst, scl, r0);
}
template <bool I8>
__device__ __forceinline__ void convert_table_q8_dyn(Frame& F, GAS const float* src, GAS unsigned char* dst, GAS float* scl, unsigned* ctr) {
    int item = 0;
    if (F.lane == 0) item = (int)__hip_atomic_fetch_add(ctr, 1u, __ATOMIC_RELAXED, __HIP_MEMORY_SCOPE_AGENT);
    item = __builtin_amdgcn_readfirstlane(item);
    while (item < PEER_E / 4) {
        int nxt = 0;
        if (F.lane == 0) nxt = (int)__hip_atomic_fetch_add(ctr, 1u, __ATOMIC_RELAXED, __HIP_MEMORY_SCOPE_AGENT);
        convert_rows4<I8>(F, src, dst, scl, item * 4);
        item = __builtin_amdgcn_readfirstlane(nxt);
    }
}
#ifndef BAR_PROBE
#define BAR_PROBE 0
#endif
#ifndef PEER_REP_ALL
#define PEER_REP_ALL 0
#endif
#ifndef PEER_REP_F
#define PEER_REP_F 0
#endif
#ifndef PEER_REP_U
#define PEER_REP_U 0
#endif
#ifndef PEER_REP_V
#define PEER_REP_V 0
#endif
#ifndef VALU_PROBE
#define VALU_PROBE 0
#endif
#ifndef SLICE_SYNC
#define SLICE_SYNC 0
#endif
constexpr int P8_NS = 16;
#define P8_ISSUE(rows, base, loff, ids) do { _Pragma("unroll") for (int i = 0; i < 16; ++i) rows[i] = *(GAS const v4u*)((base) + (((unsigned)ids[i] << 7) + (loff))); } while (0)
__device__ __forceinline__ void peer_sliced8(Frame& F) {
    GAS const char* H2 = (GAS const char*)(F.ws + WS_C); GAS const char* UT = (GAS const char*)(F.ws + WS_U8); GAS const char* VT = (GAS const char*)(F.ws + WS_V8);
    GAS const int* EID = (GAS const int*)(F.ws + WS_EID);
    GAS char* PO = (GAS char*)(F.ws + WS_A);
    GAS const float* MOD = (GAS const float*)(F.ws + WS_MOD); GAS const float* fw = F.inp(29);
    GAS float* X = F.out; GAS const float* XIN = F.inp(0); GAS const bf16* D1 = (GAS const bf16*)(F.ws + WS_D);
    const int lane = F.lane, g = lane >> 3, c = lane & 7;
    LAS int* EIDT = (LAS int*)(F.lds + F.wave * 8192);
    LAS float* ACTT = (LAS float*)(F.lds + F.wave * 8192 + 4096);
    for (int arep = 0; arep < 1 + PEER_REP_ALL; ++arep)
    for (int grp = F.vcu; grp < M / 64; grp += F.G) {
        const int tok0 = grp * 64 + F.wave * 8;
#pragma unroll
        for (int tt = 0; tt < 8; ++tt) { const unsigned eo = (unsigned)(tok0 + tt) * 128u + (unsigned)lane; EIDT[tt * 128 + lane] = EID[eo]; EIDT[tt * 128 + 64 + lane] = EID[eo + 64u]; }
        LDS_WAIT(); asm volatile("" ::: "memory");
        const unsigned c16 = (unsigned)c * 16u;
        for (int urep = 0; urep < 1 + PEER_REP_U; ++urep) {
            int acc[16];
#pragma unroll
            for (int k = 0; k < 16; ++k) acc[k] = 0;
            v4u rA[16], rB[16]; int ids[16];
            PS_LOAD_IDS(ids, 0); P8_ISSUE(rA, UT, c16, ids);
            GAS const char* H8 = (GAS const char*)(F.ws + WS_H8);
            v4u hqn = *(GAS const v4u*)(H8 + ((unsigned)(tok0 + g) * D + c16));
#pragma unroll 1
            for (int s = 0; s < P8_NS; ++s) {
                if (SLICE_SYNC) __builtin_amdgcn_s_barrier();
                const v4u hq = hqn;
                hqn = *(GAS const v4u*)(H8 + ((unsigned)(tok0 + g) * D + (unsigned)(s + 1 < P8_NS ? s + 1 : s) * 128u + c16));
                const int h0 = (int)hq.x, h1 = (int)hq.y, h2_ = (int)hq.z, h3 = (int)hq.w;
                const unsigned ubs = c16 + ((unsigned)s << 21), ubn = c16 + ((unsigned)(s + 1 < P8_NS ? s + 1 : s) << 21);
#define P8_U_STEP(b, cur, nxt) do { \
                    PS_LOAD_IDS(ids, ((b) + 1) & 7); P8_ISSUE(nxt, UT, ((b) == 7 ? ubn : ubs), ids); \
                    asm volatile("" ::: "memory"); \
                    _Pragma("unroll") for (int i = 0; i < 16; ++i) { const int w0 = (int)cur[i].x, w1 = (int)cur[i].y, w2 = (int)cur[i].z, w3 = (int)cur[i].w; \
                        int p = __builtin_amdgcn_sdot4(w0, h0, 0, false); p = __builtin_amdgcn_sdot4(w1, h1, p, false); p = __builtin_amdgcn_sdot4(w2, h2_, p, false); p = __builtin_amdgcn_sdot4(w3, h3, p, false); \
                        p += __builtin_amdgcn_update_dpp(0, p, 0xB1, 0xf, 0xf, false); p += __builtin_amdgcn_update_dpp(0, p, 0x4E, 0xf, 0xf, false); p += __builtin_amdgcn_update_dpp(0, p, 0x141, 0xf, 0xf, false); \
                        acc[(b) * 2 + (i >> 3)] += (c == (i & 7)) ? p : 0; } \
                    asm volatile("" ::: "memory"); } while (0)
                P8_U_STEP(0, rA, rB); P8_U_STEP(1, rB, rA); P8_U_STEP(2, rA, rB); P8_U_STEP(3, rB, rA);
                P8_U_STEP(4, rA, rB); P8_U_STEP(5, rB, rA); P8_U_STEP(6, rA, rB); P8_U_STEP(7, rB, rA);
#undef P8_U_STEP
            }
            unsigned long long wsl = (unsigned long long)F.ws; asm volatile("" : "+s"(wsl));
            GAS const float* GWl = (GAS const float*)((GAS unsigned char*)wsl + WS_GW); GAS const float* USC = (GAS const float*)((GAS unsigned char*)wsl + WS_USC); GAS const float* VSC = (GAS const float*)((GAS unsigned char*)wsl + WS_VSC);
            const unsigned go = (unsigned)(tok0 + g) * 128u + (unsigned)c;
            const float hsc = ((GAS const float*)((GAS unsigned char*)wsl + WS_HSC))[tok0 + g];
#pragma unroll
            for (int k = 0; k < 16; ++k) { const unsigned e = (unsigned)EIDT[g * 128 + 8 * k + c];
                ACTT[g * 128 + 8 * k + c] = gelu_tanh((float)acc[k] * (USC[e] * hsc)) * GWl[go + 8u * k] * VSC[e]; }
        }
        LDS_WAIT(); asm volatile("" ::: "memory");
        for (int vrep = 0; vrep < 1 + PEER_REP_V; ++vrep) {
            v4u rA[16], rB[16]; int ids[16]; float av[16];
            PS_LOAD_IDS(ids, 0); P8_ISSUE(rA, VT, c16, ids);
#pragma unroll 1
            for (int s = 0; s < P8_NS; ++s) {
                if (SLICE_SYNC) __builtin_amdgcn_s_barrier();
                const unsigned vbs = c16 + ((unsigned)s << 21), vbn = c16 + ((unsigned)(s + 1 < P8_NS ? s + 1 : s) << 21);
                f32x2 o[8];
#pragma unroll
                for (int k = 0; k < 8; ++k) o[k] = (f32x2){0.f, 0.f};
#define P8_V_STEP(b, cur, nxt) do { \
                    PS_LOAD_IDS(ids, ((b) + 1) & 7); P8_ISSUE(nxt, VT, ((b) == 7 ? vbn : vbs), ids); \
                    _Pragma("unroll") for (int q = 0; q < 4; ++q) { const f32x4 a4 = *(const LAS f32x4*)(ACTT + g * 128 + (b) * 16 + q * 4); av[q * 4] = a4.x; av[q * 4 + 1] = a4.y; av[q * 4 + 2] = a4.z; av[q * 4 + 3] = a4.w; } \
                    asm volatile("" ::: "memory"); \
                    _Pragma("unroll") for (int i = 0; i < 16; ++i) { const unsigned w0 = cur[i].x, w1 = cur[i].y, w2 = cur[i].z, w3 = cur[i].w; const f32x2 a2 = (f32x2){av[i], av[i]}; \
                        o[0] += a2 * __builtin_amdgcn_cvt_pk_f32_fp8((int)w0, false); o[1] += a2 * __builtin_amdgcn_cvt_pk_f32_fp8((int)w0, true); \
                        o[2] += a2 * __builtin_amdgcn_cvt_pk_f32_fp8((int)w1, false); o[3] += a2 * __builtin_amdgcn_cvt_pk_f32_fp8((int)w1, true); \
                        o[4] += a2 * __builtin_amdgcn_cvt_pk_f32_fp8((int)w2, false); o[5] += a2 * __builtin_amdgcn_cvt_pk_f32_fp8((int)w2, true); \
                        o[6] += a2 * __builtin_amdgcn_cvt_pk_f32_fp8((int)w3, false); o[7] += a2 * __builtin_amdgcn_cvt_pk_f32_fp8((int)w3, true); } \
                    if (VALU_PROBE) { _Pragma("unroll") for (int i = 0; i < 16; ++i) { unsigned w0 = cur[i].x & 0x3f3f3f3fu, w1 = cur[i].y & 0x3f3f3f3fu, w2 = cur[i].z & 0x3f3f3f3fu, w3 = cur[i].w & 0x3f3f3f3fu; asm volatile("" : "+v"(w0), "+v"(w1), "+v"(w2), "+v"(w3)); const f32x2 a2 = (f32x2){av[i] * 0.f, av[i] * 0.f}; \
                        o[0] += a2 * __builtin_amdgcn_cvt_pk_f32_fp8((int)w0, false); o[1] += a2 * __builtin_amdgcn_cvt_pk_f32_fp8((int)w0, true); \
                        o[2] += a2 * __builtin_amdgcn_cvt_pk_f32_fp8((int)w1, false); o[3] += a2 * __builtin_amdgcn_cvt_pk_f32_fp8((int)w1, true); \
                        o[4] += a2 * __builtin_amdgcn_cvt_pk_f32_fp8((int)w2, false); o[5] += a2 * __builtin_amdgcn_cvt_pk_f32_fp8((int)w2, true); \
                        o[6] += a2 * __builtin_amdgcn_cvt_pk_f32_fp8((int)w3, false); o[7] += a2 * __builtin_amdgcn_cvt_pk_f32_fp8((int)w3, true); } } \
                    asm volatile("" ::: "memory"); } while (0)
                P8_V_STEP(0, rA, rB); P8_V_STEP(1, rB, rA); P8_V_STEP(2, rA, rB); P8_V_STEP(3, rB, rA);
                P8_V_STEP(4, rA, rB); P8_V_STEP(5, rB, rA); P8_V_STEP(6, rA, rB); P8_V_STEP(7, rB, rA);
#undef P8_V_STEP
                v4u w0, w1; w0.x = pk2(o[0].x, o[0].y); w0.y = pk2(o[1].x, o[1].y); w0.z = pk2(o[2].x, o[2].y); w0.w = pk2(o[3].x, o[3].y);
                w1.x = pk2(o[4].x, o[4].y); w1.y = pk2(o[5].x, o[5].y); w1.z = pk2(o[6].x, o[6].y); w1.w = pk2(o[7].x, o[7].y);
                const unsigned po = (unsigned)(tok0 + g) * (D * 2) + (unsigned)s * 256u + (unsigned)c * 32u;
                *(GAS v4u*)(PO + po) = w0; *(GAS v4u*)(PO + po + 16u) = w1;
            }
        }
        GAS float* Xo = (arep < PEER_REP_ALL) ? (GAS float*)(F.ws + WS_A + 64 * MiB) : X;
        VM_WAIT();
        {
            static_assert(XR_EPI == 1, "the pipelined final norm reads the bf16 residual stream");
            GAS const float* g2 = MOD + (size_t)(tok0 >> 12) * NMOD + 5 * D;
            f32x4 g2v[4][2], fwv[4][2];
#pragma unroll
            for (int j = 0; j < 4; ++j) { const int col = j * 512 + lane * 8; g2v[j][0] = *(GAS const f32x4*)(g2 + col); g2v[j][1] = *(GAS const f32x4*)(g2 + col + 4); fwv[j][0] = *(GAS const f32x4*)(fw + col); fwv[j][1] = *(GAS const f32x4*)(fw + col + 4); }
            v4u xw[2][4], pw[2][4];
#pragma unroll
            for (int q = 0; q < 2; ++q)
#pragma unroll
                for (int j = 0; j < 4; ++j) { const size_t eo = (size_t)(tok0 + q) * D + j * 512 + lane * 8; xw[q][j] = *(GAS const v4u*)(D1 + eo); pw[q][j] = *(GAS const v4u*)(PO + eo * 2); }
#pragma unroll 1
            for (int tt = 0; tt < 8; tt += 2) {
                float o[2][32]; float rstd[2];
#pragma unroll
                for (int q = 0; q < 2; ++q)
#pragma unroll
                    for (int j = 0; j < 4; ++j) { const v4u dw = xw[q][j], p = pw[q][j]; const f32x4 ga = g2v[j][0], gb = g2v[j][1];
                        o[q][j * 8 + 0] = bflo(dw.x) + ga.x * bflo(p.x); o[q][j * 8 + 1] = bfhi(dw.x) + ga.y * bfhi(p.x); o[q][j * 8 + 2] = bflo(dw.y) + ga.z * bflo(p.y); o[q][j * 8 + 3] = bfhi(dw.y) + ga.w * bfhi(p.y);
                        o[q][j * 8 + 4] = bflo(dw.z) + gb.x * bflo(p.z); o[q][j * 8 + 5] = bfhi(dw.z) + gb.y * bfhi(p.z); o[q][j * 8 + 6] = bflo(dw.w) + gb.z * bflo(p.w); o[q][j * 8 + 7] = bfhi(dw.w) + gb.w * bfhi(p.w); }
                { const int tn = tt + 2 < 8 ? tt + 2 : tt;
#pragma unroll
                  for (int q = 0; q < 2; ++q)
#pragma unroll
                      for (int j = 0; j < 4; ++j) { const size_t eo = (size_t)(tok0 + tn + q) * D + j * 512 + lane * 8; xw[q][j] = *(GAS const v4u*)(D1 + eo); pw[q][j] = *(GAS const v4u*)(PO + eo * 2); } }
#pragma unroll
                for (int q = 0; q < 2; ++q) { float ss = 0.f;
#pragma unroll
                    for (int i = 0; i < 32; ++i) ss += o[q][i] * o[q][i];
                    rstd[q] = 1.0f / sqrtf(wave_sum(ss) * (1.0f / D) + EPS);
                    if (DIAG == 10 || DIAG == 11) { const float dn = *(GAS const float*)((GAS const unsigned*)(F.ws + WS_CTL) + CW_DNUM), dd = *(GAS const float*)((GAS const unsigned*)(F.ws + WS_CTL) + CW_DDEN); if (!(dn <= 0.002f * dd)) rstd[q] *= 2.0f; }
                    if (DIAG == 8 || DIAG == 9) { const float dn = *(GAS const float*)((GAS const unsigned*)(F.ws + WS_CTL) + CW_DNUM), dd = *(GAS const float*)((GAS const unsigned*)(F.ws + WS_CTL) + CW_DDEN); if (!(dn <= 0.0025f * dd)) rstd[q] *= 2.0f; } }
#pragma unroll
                for (int q = 0; q < 2; ++q) { const int tok = tok0 + tt + q;
#pragma unroll
                    for (int j = 0; j < 4; ++j) { const int col = j * 512 + lane * 8; const f32x4 wa = fwv[j][0], wb = fwv[j][1];
                        *(GAS f32x4*)(Xo + (size_t)tok * D + col) = (f32x4){o[q][j * 8 + 0] * rstd[q] * wa.x, o[q][j * 8 + 1] * rstd[q] * wa.y, o[q][j * 8 + 2] * rstd[q] * wa.z, o[q][j * 8 + 3] * rstd[q] * wa.w};
                        *(GAS f32x4*)(Xo + (size_t)tok * D + col + 4) = (f32x4){o[q][j * 8 + 4] * rstd[q] * wb.x, o[q][j * 8 + 5] * rstd[q] * wb.y, o[q][j * 8 + 6] * rstd[q] * wb.z, o[q][j * 8 + 7] * rstd[q] * wb.w}; } }
            }
        }
        LDS_WAIT(); asm volatile("" ::: "memory");
    }
}


__device__ __forceinline__ void diag8_hc(Frame& F) {
    GAS const float* MOD = (GAS const float*)(F.ws + WS_MOD) + (size_t)4 * NMOD; GAS float* HC = (GAS float*)(F.ws + WS_I);
    for (int r = F.gw; r < MC; r += F.NGW) {
        GAS const float* xr = F.inp(2) + (size_t)r * D; float v[32]; float ss = 0.f;
#pragma unroll
        for (int i = 0; i < 32; ++i) { v[i] = xr[i * 64 + F.lane]; ss += v[i] * v[i]; }
        const float rstd = 1.0f / sqrtf(wave_sum(ss) * (1.0f / D) + EPS);
#pragma unroll
        for (int i = 0; i < 32; ++i) { const int col = i * 64 + F.lane; HC[(size_t)r * D + col] = v[i] * rstd * F.inp(6)[col] * (1.0f + MOD[D + col]) + MOD[col]; }
    }
}
__device__ __forceinline__ void diag8_check(Frame& F) {
    GAS const float* HC = (GAS const float*)(F.ws + WS_I); GAS const float* W = F.inp(8); GAS const bf16* US = (GAS const bf16*)(F.ws + WS_B);
    float num = 0.f, den = 0.f;
    for (int o = (blockIdx.x * 512 + F.tid); o < MC * 1024; o += F.G * 512) {
        const int r = o >> 10, cc = o & 1023;
        float a = 0.f;
        for (int k = 0; k < D; ++k) a += HC[(size_t)r * D + k] * W[(size_t)k * INW + cc];
        const int b = r >> 8, tp = r & 255, crow = 512 + b * NCHC + (((tp >> 5) + (DIAG == 9 ? 1 : 0)) & 7), sidx = tp & 31, g = cc >> 4, hh = cc & 15;
        const float mine = bflo((unsigned)US[((size_t)g * CROWS + crow) * USLD + sidx * 16 + hh]);
        num += (a - mine) * (a - mine); den += a * a;
    }
    num = wave_sum(num); den = wave_sum(den);
    if (F.lane == 0) { atomicAdd((float*)((unsigned*)(F.ws + WS_CTL) + CW_DNUM), num); atomicAdd((float*)((unsigned*)(F.ws + WS_CTL) + CW_DDEN), den); }
}

__global__ void __launch_bounds__(NWAVES * 64, 2) fwd_kernel(Args args) {
    extern __shared__ __attribute__((aligned(16))) unsigned char lds_raw[];
    Frame F;
    F.lds = (LAS unsigned char*)lds_raw;
    F.wave0 = __builtin_amdgcn_readfirstlane((int)threadIdx.x >> 6);
    F.G = gridDim.x; { const int bx = blockIdx.x; F.vcu = (F.G % 8 == 0) ? (bx % 8) * (F.G / 8) + bx / 8 : bx; }
    F.NGW = F.G * NWAVES;
    frame_refresh(F);
    F.out = (GAS float*)args.out; F.ws = (GAS unsigned char*)args.ws;
    unsigned char* ws0 = args.ws;
    volatile LAS unsigned* MISC = (volatile LAS unsigned*)(F.lds + MISC_OFF);
    if (F.tid < 64) MISC[F.tid] = 0u;
    if (F.tid < 30) ((LAS unsigned long long*)(F.lds + TAB_OFF))[F.tid] = (unsigned long long)args.in[F.tid];
    __syncthreads();
#if MK_ONE_LAUNCH
    (void)xcd_barrier_post((unsigned*)(ws0 + WS_CTL) + CW_BAR, MISC + 8);
#endif
    const int lo = args.ph_lo, hi = args.ph_hi;
    constexpr int REPK = REP_PHASE;
    const int nsteps = (hi - lo) + ((REPK >= lo && REPK < hi) ? 1 : 0);
    for (int step = 0; step < nsteps; ++step) {
        const int ph = lo + ((REPK >= 0 && step > REPK - lo) ? step - 1 : step);
        unsigned long long wsu = (unsigned long long)args.ws, outu = (unsigned long long)args.out; int Gv = gridDim.x, bx = blockIdx.x;
        asm volatile("" : "+s"(wsu), "+s"(outu), "+s"(Gv), "+s"(bx));
        GAS unsigned char* ws = (GAS unsigned char*)wsu;
        F.ws = ws; F.out = (GAS float*)outu; F.G = Gv; F.vcu = (Gv % 8 == 0) ? (bx % 8) * (Gv / 8) + bx / 8 : bx; F.NGW = Gv * NWAVES;
        switch (ph) {

        case 0: { frame_refresh(F);
            if (F.G == 256) {
                if (bx < 128) { s5_tables(F, bx >> 1, (bx & 1) * 2, 4); s5_tables(F, bx >> 1, (bx & 1) * 2 + 1, 4); frame_refresh(F);
                    if (PEER_FP8) convert_table_q8_dyn<true>(F, F.inp(27), ws + WS_U8, (GAS float*)(ws + WS_USC), (unsigned*)(ws + WS_CTL) + CW_UCNT); }
                else { mod_full(F, bx - 128); win_amax_partials(F, F.inp(8), INW, (GAS float*)(ws + WS_WAM), (bx - 128) * NWAVES + F.wave, 128 * NWAVES); if (Q_I8) win_amax_partials(F, F.inp(24), D, (GAS float*)(ws + WS_WAMQ), (bx - 128) * NWAVES + F.wave, 128 * NWAVES); weight_transposes(F, (bx - 128) * NWAVES + F.wave, 128 * NWAVES);
                       if (PEER_FP8) convert_table_q8_dyn<true>(F, F.inp(27), ws + WS_U8, (GAS float*)(ws + WS_USC), (unsigned*)(ws + WS_CTL) + CW_UCNT); }
            } else { for (int g = bx; g < 64; g += F.G) s5_tables(F, g, 0, 1); mod_partials(F, bx, F.G); win_amax_partials(F, F.inp(8), INW, (GAS float*)(ws + WS_WAM), bx * NWAVES + F.wave, F.G * NWAVES); if (Q_I8) win_amax_partials(F, F.inp(24), D, (GAS float*)(ws + WS_WAMQ), bx * NWAVES + F.wave, F.G * NWAVES); weight_transposes(F, bx * NWAVES + F.wave, F.G * NWAVES); }
        } break;
        case 1: { frame_refresh(F); if (Gv == 256) break;
            p1_convert(F); win_transpose_q8(F, F.inp(8), INW, (GAS const float*)(ws + WS_WAM), ws + WS_WIN, (GAS float*)(ws + WS_WSC), F.gw, F.NGW);
            if (Q_I8) win_transpose_q8(F, F.inp(24), D, (GAS const float*)(ws + WS_WAMQ), ws + WS_WQ, (GAS float*)(ws + WS_WQSC), F.gw, F.NGW); } break;
        case 2: { frame_refresh(F);
            GAS const float* MOD = (GAS const float*)(ws + WS_MOD); GAS bf16* XN = (GAS bf16*)(ws + WS_C);
            if (Gv == 256) {
                win_transpose_q8(F, F.inp(8), INW, (GAS const float*)(ws + WS_WAM), ws + WS_WIN, (GAS float*)(ws + WS_WSC), F.gw, F.NGW);
                if (Q_I8) win_transpose_q8(F, F.inp(24), D, (GAS const float*)(ws + WS_WAMQ), ws + WS_WQ, (GAS float*)(ws + WS_WQSC), F.gw, F.NGW);
                for (int e = F.gw * 64 + F.lane; e < 2 * 16384; e += F.NGW * 64) { const float v = e < 16384 ? F.inp(25)[e] : F.inp(26)[e - 16384]; ((GAS bf16*)(ws + WS_K12))[e] = (bf16)f2bf(v); }
                frame_refresh(F);
            }
            for (int r0 = F.gw; r0 < MT; r0 += 2 * F.NGW) {
                GAS const float* xr[2]; GAS const float* sh[2]; GAS const float* sc[2]; GAS bf16* orow[2] = {nullptr, nullptr}; GAS const bf16* dr[2] = {nullptr, nullptr}; GAS unsigned char* qd[2]; GAS float* qs[2];
#pragma unroll
                for (int q = 0; q < 2; ++q) { int r = r0 + q * F.NGW; if (r >= MT) r = r0;
                    GAS const float* mrow;
                    if (r < M) { xr[q] = F.inp(0) + (size_t)r * D; mrow = MOD + (size_t)(r >> 12) * NMOD; } else { xr[q] = F.inp(2) + (size_t)(r - M) * D; mrow = MOD + (size_t)4 * NMOD; }
                    sh[q] = mrow; sc[q] = mrow + D; qd[q] = ws + WS_C + (size_t)r * D; qs[q] = (GAS float*)(ws + WS_XNS) + r; }
                modnorm_rows<true, 2, false>(F.lane, xr, dr, F.inp(6), sh, sc, orow, qd, qs);
            }
            if (DIAG == 8 || DIAG == 9) diag8_hc(F);
        } break;
        case 3: { frame_refresh(F);
            SchedZ S{(GAS const char*)(ws + WS_C), (GAS const char*)(ws + WS_WIN), F.G, bx};
            EpiZ E{(GAS bf16*)(ws + WS_B), (GAS bf16*)(ws + WS_G), (GAS bf16*)(ws + WS_A), (GAS const float*)(ws + WS_XNS), (GAS const float*)(ws + WS_WSC)};
            pg8::gemm_phase<PG8_ALIGN_DEFAULT, PG8_SP2_DEFAULT, true>(F.tid, F.lds, S, E, D / 2, D / 2, D / 2);
            if (PEER_FP8) {
                frame_refresh(F);
                const bool split = (F.G == 256); const int nconv = split ? F.G - 16 : F.G, cidx = split ? bx - 16 : bx;
                if (cidx >= 0) { if (!split) convert_table_q8<true>(F, F.inp(27), ws + WS_U8, (GAS float*)(ws + WS_USC), cidx * NWAVES + F.wave, nconv * NWAVES);
                                 convert_table_q8<false>(F, F.inp(28), ws + WS_V8, (GAS float*)(ws + WS_VSC), cidx * NWAVES + F.wave, nconv * NWAVES); }
            }
        } break;
        case 4: { frame_refresh(F);
            if (DIAG == 8 || DIAG == 9) { diag8_check(F); frame_refresh(F); }
            SchedS5a S{(GAS const char*)(ws + WS_B), (GAS const char*)(ws + WS_E), F.G, F.vcu};
            EpiHloc E{(GAS float*)(ws + WS_F)};
            pg8::gemm_phase(F.tid, F.lds, S, E, 512, USLD, 512);
        } break;
        case 5: { frame_refresh(F);
            if (DIAG == 7 || DIAG == 10 || DIAG == 11) s5_naive(F);
            if (F.G >= 128) { if (bx < 64) s5_scan(F, bx); else pool_prep(F, bx - 64, F.G - 64); }
            else { for (int q = bx; q < 64; q += F.G) s5_scan(F, q); pool_prep(F, bx, F.G); }
        } break;
        case 6: { frame_refresh(F);
            if (DIAG == 7) {
                GAS const float* YN = (GAS const float*)(ws + WS_YN); GAS const bf16* US = (GAS const bf16*)(ws + WS_B); GAS bf16* G1 = (GAS bf16*)(ws + WS_C + 32 * MiB); GAS const float* dsk = F.inp(16);
                for (size_t e = (size_t)F.gw * 64 + F.lane; e < (size_t)M * S5W; e += (size_t)F.NGW * 64) {
                    const int tok = (int)(e >> 10), c = (int)(e & 1023), g = c >> 4, h = c & 15, b = tok >> 12, tp = tok & 4095;
                    const float uval = bflo((unsigned)US[((size_t)g * CROWS + b * NCHL + (tp >> 5)) * USLD + (tp & 31) * 16 + h]);
                    G1[e] = (bf16)f2bf(gelu_tanh(YN[e] + dsk[c] * uval));
                }
                break;
            }
            { SchedS5c S{(GAS const char*)(ws + WS_B), (GAS const char*)(ws + WS_D), F.G, F.vcu};
              EpiS5c E{(GAS const bf16*)(ws + WS_B), (GAS bf16*)(ws + WS_C + 32 * MiB), F.inp(16), (DIAG == 10 || DIAG == 11) ? (GAS const float*)F.out : (GAS const float*)(ws + WS_END), (unsigned*)(ws + WS_CTL)};
              pg8::gemm_phase(F.tid, F.lds, S, E, 768, USLD, 768); }
        } break;
        case 7: { frame_refresh(F);
            { SchedPool S{(GAS const char*)(ws + WS_C), (GAS const char*)(ws + WS_WPOOL), F.G, F.vcu};
              EpiPool E{(GAS bf16*)(ws + WS_I), F.inp(20)};
              pg8::gemm_phase(F.tid, F.lds, S, E, 256, 1024, 256); }
        } break;
        case 8: { frame_refresh(F);
            SchedStd S{(GAS const char*)(ws + WS_C + 32 * MiB), (GAS const char*)(ws + WS_WGLU), 64, 4, F.G, bx, (size_t)256 * 1024 * 2, (size_t)256 * 1024 * 2};
            EpiGlu E{(GAS const bf16*)(ws + WS_C + 32 * MiB), (GAS bf16*)(ws + WS_G), F.inp(18)};
            pg8::gemm_phase(F.tid, F.lds, S, E, 1024, 1024, 1024);
        } break;
        case 9: { frame_refresh(F);
            SchedMerge S{(GAS const char*)(ws + WS_G), (GAS const char*)(ws + WS_I), (GAS const char*)(ws + WS_PROJA), (GAS const char*)(ws + WS_PROJB), F.G, bx};
            EpiMerge2 E{(GAS const bf16*)(ws + WS_A), (GAS bf16*)(ws + WS_B)};
            pg8::gemm_phase(F.tid, F.lds, S, E, 1024, 1024, 1024);
        } break;
        case 10: break;
        case 11: { frame_refresh(F);
            SchedStd S{(GAS const char*)(ws + WS_B), (GAS const char*)(ws + WS_WOUT), 64, 8, F.G, bx, (size_t)256 * D * 2, (size_t)256 * D * 2};
            EpiWout E{(GAS bf16*)(ws + WS_D), (GAS const float*)(ws + WS_MOD), F.inp(0)};
            pg8::gemm_phase(F.tid, F.lds, S, E, D, D, D);
        } break;
        case 12: { frame_refresh(F);
            GAS const float* MOD = (GAS const float*)(ws + WS_MOD); GAS bf16* H2 = (GAS bf16*)(ws + WS_C);
            for (int r0 = F.gw; r0 < M; r0 += 2 * F.NGW) {
                GAS const float* xr[2]; GAS const bf16* dr[2]; GAS const float* sh[2]; GAS const float* sc[2]; GAS bf16* orow[2]; GAS unsigned char* qd[2]; GAS float* qs[2];
#pragma unroll
                for (int q = 0; q < 2; ++q) { const int r = r0 + q * F.NGW; GAS const float* mrow = MOD + (size_t)(r >> 12) * NMOD;
                    xr[q] = F.inp(0) + (size_t)r * D; dr[q] = (GAS const bf16*)(ws + WS_D) + (size_t)r * D; sh[q] = mrow + 3 * D; sc[q] = mrow + 4 * D; orow[q] = H2 + (size_t)r * D; qd[q] = ws + WS_H8 + (size_t)r * D; qs[q] = (GAS float*)(ws + WS_HSC) + r; }
                modnorm_rows<PEER_FP8 != 0, 2, !(Q_I8 && PEER_FP8), XR_EPI ? 2 : 1>(F.lane, xr, dr, F.inp(7), sh, sc, orow, qd, qs);
            }
            if (PEER_FP8) {   }
            else { convert_table(F, F.inp(27), (GAS bf16*)(ws + WS_D), (size_t)PEER_E * D); convert_table(F, F.inp(28), (GAS bf16*)(ws + WS_B), (size_t)PEER_E * D); }
        } break;
        case 13: { frame_refresh(F);
            if (Q_I8) {
                SchedStd S{(GAS const char*)(ws + WS_H8), (GAS const char*)(ws + WS_WQ), 64, 8, F.G, bx, (size_t)256 * D, (size_t)256 * D};
                EpiQ8 E{(GAS bf16*)(ws + WS_A), (GAS const float*)(ws + WS_HSC), (GAS const float*)(ws + WS_WQSC)};
                pg8::gemm_phase<PG8_ALIGN_DEFAULT, PG8_SP2_DEFAULT, true>(F.tid, F.lds, S, E, D / 2, D / 2, D / 2);
            } else {
            SchedStd S{(GAS const char*)(ws + WS_C), (GAS const char*)(ws + WS_WQ), 64, 8, F.G, bx, (size_t)256 * D * 2, (size_t)256 * D * 2};
            EpiQ E{(GAS bf16*)(ws + WS_A)};
            pg8::gemm_phase(F.tid, F.lds, S, E, D, D, D);
            }
        } break;
        case 14: { frame_refresh(F); peer_topk(F); } break;
        case 15: { frame_refresh(F); if (PEER_FP8) peer_sliced8(F); else if (PEER_V2) peer_sliced(F); else peer_gather(F); } break;
        default: break;
        }
#if MK_ONE_LAUNCH
        if (step + 1 < nsteps && ph == 14 && Gv == 256 && PEER_FP8) { asm volatile("s_waitcnt vmcnt(0)" ::: "memory"); __syncthreads(); }
        else if (step + 1 < nsteps && ph != 6 && ph != 10 && !(ph == 1 && Gv == 256)) { unsigned long long bu = (unsigned long long)(ws + WS_CTL); asm volatile("" : "+s"(bu));
            XcdBarrier b2; b2.bar = (unsigned*)bu + CW_BAR; b2.x = xb_xcc_id(); b2.st = (volatile LAS unsigned*)(F.lds + MISC_OFF) + 8; frame_refresh(F); xcd_barrier(b2, F.tid);
            if (BAR_PROBE && ph == 2) { for (int q = 0; q < 4; ++q) xcd_barrier(b2, F.tid); } }
#endif
    }
}

extern "C" void kernel_launch(void* const* d_in, const int* in_sizes, int n_in, void* d_out, int out_size, void* d_ws, size_t ws_size, hipStream_t stream) {
    static int grid = 0;
    if (grid == 0) {
        if (n_in != 30 || in_sizes[0] != M * D || out_size != M * D || ws_size < WS_END + (DIAG == 7 ? 64 * MiB : 0)) {
            fprintf(stderr, "kernel_launch: unexpected shapes: n_in %d in0 %d out %d ws %zu (need %zu); nothing launched\n", n_in, n_in > 0 ? in_sizes[0] : -1, out_size, ws_size, (size_t)WS_END); grid = -1; return; }
        int dev = 0, cus = 0, per_cu = 0;
        if (hipGetDevice(&dev) != hipSuccess || hipDeviceGetAttribute(&cus, hipDeviceAttributeMultiprocessorCount, dev) != hipSuccess) { fprintf(stderr, "kernel_launch: device query failed\n"); grid = -1; return; }
        if (hipFuncSetAttribute((const void*)fwd_kernel, hipFuncAttributeMaxDynamicSharedMemorySize, LDS_BYTES) != hipSuccess) { fprintf(stderr, "kernel_launch: hipFuncSetAttribute failed\n"); grid = -1; return; }
        if (hipOccupancyMaxActiveBlocksPerMultiprocessor(&per_cu, (const void*)fwd_kernel, NWAVES * 64, LDS_BYTES) != hipSuccess || per_cu < 1) {
            fprintf(stderr, "kernel_launch: occupancy query reports %d workgroups per CU\n", per_cu); }
        (void)hipGetLastError();
        grid = cus;
    }
    if (grid < 0) return;
    if (hipMemsetAsync((char*)d_ws + WS_CTL, 0, CTL_ZERO_BYTES, stream) != hipSuccess) { fprintf(stderr, "kernel_launch: memset failed\n"); return; }
    Args a{};
    for (int i = 0; i < 30; ++i) a.in[i] = (const float*)d_in[i];
    a.out = (float*)d_out; a.ws = (unsigned char*)d_ws;
#if MK_ONE_LAUNCH
    a.ph_lo = 0; a.ph_hi = NPHASES;
    hipLaunchKernelGGL(fwd_kernel, dim3(grid), dim3(NWAVES * 64), LDS_BYTES, stream, a);
#else
    for (int p = 0; p < NPHASES; ++p) { a.ph_lo = p; a.ph_hi = p + 1; hipLaunchKernelGGL(fwd_kernel, dim3(grid), dim3(NWAVES * 64), LDS_BYTES, stream, a); }
#endif
    const hipError_t le = hipPeekAtLastError();
    if (le != hipSuccess) fprintf(stderr, "kernel_launch: launch failed: %s\n", hipGetErrorName(le));
}
```

```cpp
#include <hip/hip_runtime.h>
#include <cstdio>
#include <cstdint>

#ifndef Q_I8
#define Q_I8 1
#endif
#ifndef MOD_HANDOFF
#define MOD_HANDOFF 1
#endif
#ifndef MERGE_CHAIN
#define MERGE_CHAIN 1
#endif
#ifndef WOUT_CHAIN
#define WOUT_CHAIN 1
#endif
#ifndef GATES_U8
#define GATES_U8 1
#endif
#ifndef XR_EPI
#define XR_EPI 1
#endif
#ifndef P0_REP
#define P0_REP 0
#endif
#ifndef REP_PHASE
#define REP_PHASE -1
#endif
#ifndef PEER_V2
#define PEER_V2 1
#endif
#ifndef DIAG
#define DIAG 0
#endif
#ifndef MK_ONE_LAUNCH
#define MK_ONE_LAUNCH 1
#endif

#define GAS __attribute__((address_space(1)))
#define LAS __attribute__((address_space(3)))
typedef unsigned short bf16;
typedef unsigned v4u __attribute__((ext_vector_type(4)));
typedef unsigned v2u __attribute__((ext_vector_type(2)));
typedef float f32x4 __attribute__((ext_vector_type(4)));
typedef int i32x4 __attribute__((ext_vector_type(4)));
typedef float f32x2 __attribute__((ext_vector_type(2)));
typedef short bf16x8 __attribute__((ext_vector_type(8)));
typedef __bf16 bf16x2_t __attribute__((ext_vector_type(2)));

constexpr int D = 2048, NB = 4, SEQ = 4096, M = NB * SEQ;
constexpr int CTXL = 256, MC = NB * CTXL, MT = M + MC;
constexpr int INW = 6144, NMOD = 6 * D;
constexpr int S5W = 1024, S5G = 64, S5P = 64, S5H = 16, TCH = 32;
constexpr int NCHL = SEQ / TCH, NCHC = CTXL / TCH;
constexpr int CROWS = 768;
constexpr int USLD = 768;
constexpr int PEER_E = 16384, PEER_H = 8, PEER_K = 16;
constexpr float EPS = 1e-6f;
constexpr int KS_MOD = 32;

constexpr size_t MiB = 1u << 20;
constexpr size_t WS_CTL = 0, CTL_ZERO_BYTES = 1 * MiB;
constexpr size_t WS_MODP = 1 * MiB;
constexpr size_t WS_MOD = 9 * MiB;
constexpr size_t WS_K12 = 10 * MiB;
constexpr size_t WS_XNS = WS_K12 + 384 * 1024, WS_WSC = WS_K12 + 512 * 1024;
constexpr size_t WS_WAM = WS_MODP + 7680 * 1024;
constexpr size_t WS_WAMQ = WS_WAM + 384 * 1024;
constexpr size_t WS_WQSC = WS_K12 + 640 * 1024;
constexpr size_t WS_WIN = 11 * MiB;
constexpr size_t WS_WGLU = 35 * MiB;
constexpr size_t WS_WPOOL = 37 * MiB;
constexpr size_t WS_PROJA = 38 * MiB;
constexpr size_t WS_PROJB = 42 * MiB;
constexpr size_t WS_WOUT = 46 * MiB;
constexpr size_t WS_WQ = 54 * MiB;
constexpr size_t WS_EID = 62 * MiB;
constexpr size_t WS_GW = 70 * MiB;
constexpr size_t WS_A = 78 * MiB;
constexpr size_t WS_B = 206 * MiB;
constexpr size_t WS_C = 278 * MiB;
constexpr size_t WS_D = 346 * MiB;
constexpr size_t WS_E = 394 * MiB;
constexpr size_t WS_F = 410 * MiB;
constexpr size_t WS_G = 458 * MiB;
constexpr size_t WS_I = 490 * MiB;
constexpr size_t WS_T8 = 522 * MiB;
constexpr size_t WS_END = 586 * MiB;
constexpr int CW_TMO = 0, CW_BAR = 4096;
constexpr int CW_MODRDY = 160;
constexpr int CW_GLURDY = 8192;
constexpr int CW_MMRDY = 12288;
constexpr int CW_UCNT = 96;
constexpr int CW_DNUM = 64, CW_DDEN = 65;

constexpr int LDS_BYTES = 147456;
constexpr int MISC_OFF = LDS_BYTES - 256;
constexpr int TAB_OFF = LDS_BYTES - 1024;
constexpr int NWAVES = 8;
constexpr int NPHASES = 16;

#define RLX_AGENT __ATOMIC_RELAXED, __HIP_MEMORY_SCOPE_AGENT
#define LDS_WAIT() asm volatile("s_waitcnt lgkmcnt(0)" ::: "memory")
#define VM_WAIT() asm volatile("s_waitcnt vmcnt(0)" ::: "memory")
__device__ __forceinline__ unsigned f2bf(float f) { return (unsigned)__builtin_bit_cast(unsigned short, (__bf16)f); }
__device__ __forceinline__ unsigned pk2(float lo, float hi) { return __builtin_bit_cast(unsigned, __builtin_convertvector((f32x2){lo, hi}, bf16x2_t)); }
__device__ __forceinline__ float bflo(unsigned w) { return __builtin_bit_cast(float, w << 16); }
__device__ __forceinline__ float bfhi(unsigned w) { return __builtin_bit_cast(float, w & 0xffff0000u); }
__device__ __forceinline__ float sigmoidf_(float x) { return __builtin_amdgcn_rcpf(1.0f + __expf(-x)); }
__device__ __forceinline__ float gelu_tanh(float x) { const float y = 1.5957691216057308f * (x + 0.044715f * x * x * x); return x * __builtin_amdgcn_rcpf(1.0f + __expf(-y)); }
#define DPP_ADD(v, ctrl) (v) += __builtin_bit_cast(float, __builtin_amdgcn_update_dpp(0, __builtin_bit_cast(int, (v)), (ctrl), 0xf, 0xf, false))
__device__ __forceinline__ float wave_sum(float v) {
    DPP_ADD(v, 0xB1);
    DPP_ADD(v, 0x4E);
    DPP_ADD(v, 0x124);
    DPP_ADD(v, 0x128);
    v += __builtin_bit_cast(float, __builtin_amdgcn_ds_swizzle(__builtin_bit_cast(int, v), 0x401F));
    return __builtin_bit_cast(float, __builtin_amdgcn_readlane(__builtin_bit_cast(int, v), 0)) + __builtin_bit_cast(float, __builtin_amdgcn_readlane(__builtin_bit_cast(int, v), 32));
}
__device__ __forceinline__ float wave_max(float v) {
#define DPP_MAXF(v, ctrl) (v) = fmaxf((v), __builtin_bit_cast(float, __builtin_amdgcn_update_dpp(0, __builtin_bit_cast(int, (v)), (ctrl), 0xf, 0xf, false)))
    DPP_MAXF(v, 0xB1); DPP_MAXF(v, 0x4E); DPP_MAXF(v, 0x124); DPP_MAXF(v, 0x128);
    v = fmaxf(v, __builtin_bit_cast(float, __builtin_amdgcn_ds_swizzle(__builtin_bit_cast(int, v), 0x401F)));
    return fmaxf(__builtin_bit_cast(float, __builtin_amdgcn_readlane(__builtin_bit_cast(int, v), 0)), __builtin_bit_cast(float, __builtin_amdgcn_readlane(__builtin_bit_cast(int, v), 32)));
#undef DPP_MAXF
}
__device__ __forceinline__ float shfl_idx(float v, int src_lane) { return __builtin_bit_cast(float, __builtin_amdgcn_ds_bpermute(src_lane << 2, __builtin_bit_cast(int, v))); }
__device__ __forceinline__ int shfl_idx_i(int v, int src_lane) { return __builtin_amdgcn_ds_bpermute(src_lane << 2, v); }

#ifndef PG8_ALIGN_DEFAULT
#define PG8_ALIGN_DEFAULT true
#endif
#ifndef PG8_SP2_DEFAULT
#define PG8_SP2_DEFAULT true
#endif
template <class S_, class U_> __device__ __forceinline__ auto sched_ready(const S_& s, const U_& u, int) -> decltype(s.ready(u), void()) { s.ready(u); }
template <class S_, class U_> __device__ __forceinline__ void sched_ready(const S_&, const U_&, long) {}
namespace pg8 {
constexpr int BM = 256, BK = 64, HALF = 128, HTB = HALF * BK * 2, STAGE_BYTES = 8 * HTB, NXCD = 8, WGM = 8;
__host__ __device__ __forceinline__ int lds_byte(int r, int c) { const int st = (r >> 4) * 2 + (c >> 5), rr = r & 15, cc = c & 31, ob = rr * 64 + cc * 2; return st * 1024 + (ob ^ (((ob >> 9) & 1) << 5)); }
__host__ __device__ __forceinline__ void stage_rc(int b, int& R, int& C) { const int st = b / 1024, sb = b % 1024, swz = sb ^ (((sb >> 9) & 1) << 5); R = (st >> 1) * 16 + swz / 64; C = (st & 1) * 32 + (swz % 64) / 2; }
__host__ __device__ __forceinline__ int perm32(int rho) { const int n = rho >> 4, i = rho & 15; return 8 * (i >> 2) + 4 * n + (i & 3); }
struct Unit { int pm, pn, g; };

__device__ __forceinline__ void std_order(int L, int nM, int nN, int& pm, int& pn) {
    const int nwg = nM * nN; int wgid = L;
    { const int q = nwg / NXCD, r = nwg % NXCD, xcd = wgid % NXCD, off = wgid / NXCD; wgid = (xcd < r ? xcd * (q + 1) : r * (q + 1) + (xcd - r) * q) + off; }
    const int nig = WGM * nN, gid = wgid / nig, fm = gid * WGM, gsz = (nM - fm) < WGM ? (nM - fm) : WGM;
    pm = fm + ((wgid % nig) % gsz); pn = (wgid % nig) / gsz;
}

template <bool ALIGN_EPI = PG8_ALIGN_DEFAULT, bool SP2 = PG8_SP2_DEFAULT, bool I8 = false, class Epi, class Sched>
__device__ __forceinline__ void gemm_phase(const int tid, LAS unsigned char* lds, const Sched& S, const Epi& E, const int K, const int lda, const int ldb) {
    const int wid = __builtin_amdgcn_readfirstlane(tid >> 6), lane = tid & 63, wr = wid >> 2, wc = wid & 3, fr = lane & 15, fq = lane >> 4;
    const int nt = K / BK;
    unsigned voffA[2], voffB[2];
#pragma unroll
    for (int i = 0; i < 2; ++i) { int R, C; stage_rc(tid * 16 + i * 8192, R, C); const int Rb = Epi::PERM ? ((R & ~31) + perm32(R & 31)) : R;
        voffA[i] = (unsigned)(R * lda + C) * 2u; voffB[i] = (unsigned)(Rb * ldb + C) * 2u; }
    const size_t kstep = (size_t)(BK * 2);
    const size_t hstepA = (size_t)HALF * lda * 2, hstepB = (size_t)HALF * ldb * 2;
    const unsigned ldsw = (unsigned)wid * 1024u;
    const int aoff = lds_byte(wr * 64 + fr, fq * 8), boff = lds_byte(wc * 32 + fr, fq * 8);
#define PG8_SA(b, h) (((b) * 2 + (h)) * HTB)
#define PG8_SB(b, h) ((4 + (b) * 2 + (h)) * HTB)
#define PG8_STAGE(bufoff, gbase, voff) do { _Pragma("unroll") for (int _i = 0; _i < 2; ++_i) \
        __builtin_amdgcn_global_load_lds((const unsigned*)((GAS const char*)(gbase) + (voff)[_i]), (LAS unsigned*)(lds + (bufoff) + ldsw + _i * 8192), 16, 0, 0); } while (0)
#define PG8_LDA(dst, b, h) do { _Pragma("unroll") for (int m = 0; m < 4; ++m) _Pragma("unroll") for (int k = 0; k < 2; ++k) dst[m][k] = *(const LAS bf16x8*)(lds + PG8_SA(b, h) + aoff + m * 2048 + k * 1024); } while (0)
#define PG8_LDB(dst, b, h) do { _Pragma("unroll") for (int n = 0; n < 2; ++n) _Pragma("unroll") for (int k = 0; k < 2; ++k) dst[n][k] = *(const LAS bf16x8*)(lds + PG8_SB(b, h) + boff + n * 2048 + k * 1024); } while (0)
#define PG8_MMA(ai, bj, At, Bt) do { __builtin_amdgcn_s_setprio(1); _Pragma("unroll") for (int m = 0; m < 4; ++m) _Pragma("unroll") for (int n = 0; n < 2; ++n) _Pragma("unroll") for (int k = 0; k < 2; ++k) { \
        if constexpr (I8) acc[ai][bj][m][n] = __builtin_bit_cast(f32x4, __builtin_amdgcn_mfma_i32_16x16x64_i8(__builtin_bit_cast(i32x4, Bt[n][k]), __builtin_bit_cast(i32x4, At[m][k]), __builtin_bit_cast(i32x4, acc[ai][bj][m][n]), 0, 0, 0)); \
        else acc[ai][bj][m][n] = __builtin_amdgcn_mfma_f32_16x16x32_bf16(Bt[n][k], At[m][k], acc[ai][bj][m][n], 0, 0, 0); } __builtin_amdgcn_s_setprio(0); } while (0)
#define PG8_WAIT_V(n) asm volatile("s_waitcnt vmcnt(" #n ")" ::: "memory")
#define PG8_WAIT_L(n) asm volatile("s_waitcnt lgkmcnt(" #n ")" ::: "memory")
#define PG8_BAR __builtin_amdgcn_s_barrier()
#define PG8_SCHED __builtin_amdgcn_sched_barrier(0)
    Unit cur, nxt; int ui = 0;
    if (!S.next(0, cur)) return;
    ::sched_ready(S, cur, 0);
    f32x4 acc[2][2][4][2];
#pragma unroll
    for (int a = 0; a < 2; ++a)
#pragma unroll
        for (int b = 0; b < 2; ++b)
#pragma unroll
            for (int m = 0; m < 4; ++m)
#pragma unroll
                for (int n = 0; n < 2; ++n) acc[a][b][m][n] = (f32x4){0.f, 0.f, 0.f, 0.f};
    bf16x8 At[4][2], B0[2][2], B1[2][2];
    GAS const char* cA = S.a_tile(cur); GAS const char* cB = S.b_tile(cur);
    if constexpr (SP2) {
        PG8_STAGE(PG8_SB(0, 0), cB, voffB); PG8_STAGE(PG8_SB(0, 1), cB + hstepB, voffB); PG8_STAGE(PG8_SA(0, 0), cA, voffA); PG8_STAGE(PG8_SA(0, 1), cA + hstepA, voffA);
        if (wr == 1) PG8_BAR;
        PG8_WAIT_V(2); PG8_BAR;
        PG8_STAGE(PG8_SB(1, 0), cB + kstep, voffB); PG8_STAGE(PG8_SA(1, 0), cA + kstep, voffA); PG8_STAGE(PG8_SB(1, 1), cB + hstepB + kstep, voffB);
        PG8_WAIT_V(6); PG8_BAR;
    } else {
        PG8_STAGE(PG8_SB(0, 0), cB, voffB); PG8_STAGE(PG8_SA(0, 0), cA, voffA); PG8_STAGE(PG8_SB(0, 1), cB + hstepB, voffB); PG8_STAGE(PG8_SA(0, 1), cA + hstepA, voffA);
        if (wr == 1) PG8_BAR;
        PG8_WAIT_V(4); PG8_BAR;
        PG8_STAGE(PG8_SB(1, 0), cB + kstep, voffB); PG8_STAGE(PG8_SA(1, 0), cA + kstep, voffA); PG8_STAGE(PG8_SB(1, 1), cB + hstepB + kstep, voffB);
        PG8_WAIT_V(6); PG8_BAR;
    }
    for (;;) {
        const bool has_next = S.next(ui + 1, nxt);
        GAS const char* nA = has_next ? S.a_tile(nxt) : cA; GAS const char* nB = has_next ? S.b_tile(nxt) : cB;
#pragma unroll 1
        for (int t = 0; t < nt; t += 2) {
            const bool last = (t == nt - 2);
            GAS const char* a1 = cA + (size_t)(t + 1) * kstep;
            GAS const char* a2 = last ? nA : cA + (size_t)(t + 2) * kstep; GAS const char* b2 = last ? nB : cB + (size_t)(t + 2) * kstep;
            GAS const char* a3 = a2 + kstep; GAS const char* b3 = b2 + kstep;
            if (last && has_next) ::sched_ready(S, nxt, 0);
            if constexpr (SP2) {
            PG8_LDB(B0, 0, 0); PG8_LDB(B1, 0, 1); PG8_SCHED; PG8_LDA(At, 0, 0); PG8_STAGE(PG8_SA(1, 1), a1 + hstepA, voffA);
            PG8_WAIT_V(8); PG8_WAIT_L(0); PG8_BAR; PG8_MMA(0, 0, At, B0); PG8_MMA(0, 1, At, B1); PG8_BAR; PG8_SCHED;
            PG8_LDA(At, 0, 1); PG8_STAGE(PG8_SB(0, 0), b2, voffB); PG8_STAGE(PG8_SB(0, 1), b2 + hstepB, voffB); PG8_STAGE(PG8_SA(0, 0), a2, voffA);
            PG8_WAIT_V(8); PG8_WAIT_L(0); PG8_BAR; PG8_MMA(1, 0, At, B0); PG8_MMA(1, 1, At, B1); PG8_BAR; PG8_SCHED;
            PG8_LDB(B0, 1, 0); PG8_LDB(B1, 1, 1); PG8_SCHED; PG8_LDA(At, 1, 0); PG8_STAGE(PG8_SA(0, 1), a2 + hstepA, voffA);
            PG8_WAIT_V(8); PG8_WAIT_L(0); PG8_BAR; PG8_MMA(0, 0, At, B0); PG8_MMA(0, 1, At, B1); PG8_BAR; PG8_SCHED;
            PG8_LDA(At, 1, 1); PG8_STAGE(PG8_SB(1, 0), b3, voffB); PG8_STAGE(PG8_SB(1, 1), b3 + hstepB, voffB); PG8_STAGE(PG8_SA(1, 0), a3, voffA);
            PG8_WAIT_V(8); PG8_WAIT_L(0); PG8_BAR; PG8_MMA(1, 0, At, B0); PG8_MMA(1, 1, At, B1); PG8_BAR; PG8_SCHED;
            } else {
            PG8_LDB(B0, 0, 0); PG8_SCHED; PG8_LDA(At, 0, 0); PG8_STAGE(PG8_SA(1, 1), a1 + hstepA, voffA);
            PG8_WAIT_L(8); PG8_BAR; PG8_WAIT_L(0); PG8_MMA(0, 0, At, B0); PG8_BAR; PG8_SCHED;
            PG8_LDB(B1, 0, 1); PG8_STAGE(PG8_SB(0, 0), b2, voffB);
            PG8_BAR; PG8_WAIT_L(0); PG8_MMA(0, 1, At, B1); PG8_BAR;
            PG8_LDA(At, 0, 1); PG8_STAGE(PG8_SA(0, 0), a2, voffA);
            PG8_BAR; PG8_WAIT_L(0); PG8_MMA(1, 0, At, B0); PG8_BAR; PG8_SCHED;
            PG8_STAGE(PG8_SB(0, 1), b2 + hstepB, voffB);
            PG8_WAIT_V(6); PG8_BAR; PG8_MMA(1, 1, At, B1); PG8_BAR;
            PG8_LDB(B0, 1, 0); PG8_SCHED; PG8_LDA(At, 1, 0); PG8_STAGE(PG8_SA(0, 1), a2 + hstepA, voffA);
            PG8_WAIT_L(8); PG8_BAR; PG8_WAIT_L(0); PG8_MMA(0, 0, At, B0); PG8_BAR; PG8_SCHED;
            PG8_LDB(B1, 1, 1); PG8_STAGE(PG8_SB(1, 0), b3, voffB);
            PG8_BAR; PG8_WAIT_L(0); PG8_MMA(0, 1, At, B1); PG8_BAR;
            PG8_LDA(At, 1, 1); PG8_STAGE(PG8_SA(1, 0), a3, voffA);
            PG8_BAR; PG8_WAIT_L(0); PG8_MMA(1, 0, At, B0); PG8_BAR; PG8_SCHED;
            PG8_STAGE(PG8_SB(1, 1), b3 + hstepB, voffB);
            PG8_WAIT_V(6); PG8_BAR; PG8_MMA(1, 1, At, B1); PG8_BAR;
            }
        }
        if constexpr (ALIGN_EPI) { if (wr == 0) PG8_BAR; }
        bool keep = false;
        if constexpr (Epi::DUAL) { if (cur.g == 0) { E.mid(acc, cur, wr, wc, fr, fq); keep = true; } else E(acc, cur, wr, wc, fr, fq); }
        else E(acc, cur, wr, wc, fr, fq);
        if (!has_next) break;
        if (!keep) {
#pragma unroll
        for (int a = 0; a < 2; ++a)
#pragma unroll
            for (int b = 0; b < 2; ++b)
#pragma unroll
                for (int m = 0; m < 4; ++m)
#pragma unroll
                    for (int n = 0; n < 2; ++n) acc[a][b][m][n] = (f32x4){0.f, 0.f, 0.f, 0.f};
        }
        cur = nxt; cA = nA; cB = nB; ++ui;
        if constexpr (ALIGN_EPI) { if (wr == 1) PG8_BAR; }
    }
    PG8_WAIT_V(0);
    if constexpr (!ALIGN_EPI) { if (wr == 0) PG8_BAR; }
    PG8_BAR;
#undef PG8_SA
#undef PG8_SB
#undef PG8_STAGE
#undef PG8_LDA
#undef PG8_LDB
#undef PG8_MMA
#undef PG8_WAIT_V
#undef PG8_WAIT_L
#undef PG8_BAR
#undef PG8_SCHED
}
}
using pg8::Unit;

#define XB_TMO      128
#define XB_XCNT(j)  (256  + 64 * (j))
#define XB_XSUB(j)  (1280 + 64 * (j))
#define XB_XGEN(j)  (2304 + 64 * (j))
#define XB_TOP      3328
#define XB_TOPGEN   3392
#define XCD_BAR_WORDS 3456
#define XB_SPIN_CAP (1u << 20)
__device__ __forceinline__ unsigned xb_ld(unsigned* p)              { return __hip_atomic_load(p, __ATOMIC_RELAXED, __HIP_MEMORY_SCOPE_AGENT); }
__device__ __forceinline__ unsigned xb_add(unsigned* p, unsigned v) { return __hip_atomic_fetch_add(p, v, __ATOMIC_RELAXED, __HIP_MEMORY_SCOPE_AGENT); }
__device__ __forceinline__ unsigned xb_xcc_id() { return (unsigned)__builtin_amdgcn_s_getreg((3 << 11) | 20) & 0xFu; }
#define XB_SPIN(cond, bar) do { unsigned _sp = 0; while (cond) { __builtin_amdgcn_s_sleep(1); \
    if ((++_sp & 255u) == 0u) { if (xb_ld(&(bar)[XB_TMO])) break; if (_sp > XB_SPIN_CAP) { atomicAdd(&(bar)[XB_TMO], 1u); break; } } } } while (0)
struct XcdBarrier { unsigned* bar; unsigned x; volatile LAS unsigned* st; };
__device__ __forceinline__ XcdBarrier xcd_barrier_post(unsigned* bar, volatile LAS unsigned* st) {
    XcdBarrier b; b.bar = bar; b.x = xb_xcc_id(); b.st = st;
    if (threadIdx.x == 0) (void)xb_add(&bar[XB_XCNT(b.x)], 1u);
    return b;
}
__device__ __forceinline__ void xcd_barrier_complete(unsigned* bar, unsigned x, unsigned& nloc, unsigned& nx) {
    const unsigned G = gridDim.x * gridDim.y * gridDim.z;
    unsigned sum, cnt, mine, sp = 0u;
    for (;;) {
        sum = 0u; cnt = 0u; mine = 0u;
#pragma unroll
        for (unsigned j = 0; j < 16; ++j) { const unsigned c = xb_ld(&bar[XB_XCNT(j)]); sum += c; cnt += (c > 0u) ? 1u : 0u; mine = (j == x) ? c : mine; }
        if (sum == G) break;
        __builtin_amdgcn_s_sleep(1);
        if ((++sp & 255u) == 0u) { if (xb_ld(&bar[XB_TMO])) break; if (sp > XB_SPIN_CAP) { atomicAdd(&bar[XB_TMO], 1u); break; } }
    }
    nloc = mine > 0u ? mine : 1u; nx = cnt > 0u ? cnt : 1u;
}
__device__ __forceinline__ void xcd_barrier(const XcdBarrier& b, const int tid) {
    asm volatile("s_waitcnt vmcnt(0)" ::: "memory");
    __syncthreads();
    if (tid == 0) {
        unsigned* bar = b.bar;
        __builtin_amdgcn_s_waitcnt(0);
        unsigned nloc = b.st[0], nx = b.st[1];
        if (nloc == 0u) { xcd_barrier_complete(bar, b.x, nloc, nx); b.st[0] = nloc; b.st[1] = nx; }
        const unsigned old = xb_add(&bar[XB_XSUB(b.x)], 1u);
        const unsigned gen = old / nloc;
        if (old + 1u == (gen + 1u) * nloc) {
            __builtin_amdgcn_fence(__ATOMIC_RELEASE, "agent");
            asm volatile("s_waitcnt vmcnt(0)" ::: "memory");
            const unsigned og = xb_add(&bar[XB_TOP], 1u);
            const unsigned tg = og / nx;
            if (og + 1u == (tg + 1u) * nx) xb_add(&bar[XB_TOPGEN], 1u);
            else XB_SPIN(xb_ld(&bar[XB_TOPGEN]) == tg, bar);
            __builtin_amdgcn_fence(__ATOMIC_ACQUIRE, "agent");
            xb_add(&bar[XB_XGEN(b.x)], 1u);
            asm volatile("s_waitcnt vmcnt(0)" ::: "memory");
        } else {
            XB_SPIN(xb_ld(&bar[XB_XGEN(b.x)]) == gen, bar);
            __builtin_amdgcn_fence(__ATOMIC_ACQUIRE, "agent");
            asm volatile("s_waitcnt vmcnt(0)" ::: "memory");
        }
    }
    __syncthreads();
}

struct Args { const float* in[30]; float* out; unsigned char* ws; int ph_lo, ph_hi; };
struct Frame {
    LAS unsigned char* lds;
    int tid, lane, wave, wave0, vcu, G, gw, NGW;
    GAS float* out; GAS unsigned char* ws;
    __device__ __forceinline__ GAS const float* inp(int i) const { return (GAS const float*)(((volatile LAS unsigned long long*)(lds + TAB_OFF))[i]); }
};

__device__ __forceinline__ bool frame_refresh(Frame& F) { unsigned z = 0u; asm volatile("" : "+v"(z));
    int t = (F.wave0 << 6) | (int)__builtin_amdgcn_mbcnt_hi(~0u, __builtin_amdgcn_mbcnt_lo(~0u, z));
    F.tid = t; F.lane = t & 63; F.wave = __builtin_amdgcn_readfirstlane(t >> 6); F.gw = F.vcu * NWAVES + F.wave; return true; }
struct SchedStd {
    GAS const char* A; GAS const char* Bt; int nM, nN, G, c; size_t tA, tB;
    __device__ __forceinline__ bool next(int i, Unit& u) const { const int L = i * G + c; if (L >= nM * nN) return false; pg8::std_order(L, nM, nN, u.pm, u.pn); u.g = 0; return true; }
    __device__ __forceinline__ GAS const char* a_tile(const Unit& u) const { return A + (size_t)u.pm * tA; }
    __device__ __forceinline__ GAS const char* b_tile(const Unit& u) const { return Bt + (size_t)u.pn * tB; }
};
struct SchedWout {
    GAS const char* A; GAS const char* Bt; int nM, nN, G, c; size_t tA, tB; GAS unsigned* cnt;
    __device__ __forceinline__ bool next(int i, Unit& u) const { const int L = i * G + c; if (L >= nM * nN) return false; pg8::std_order(L, nM, nN, u.pm, u.pn); u.g = 0; return true; }
    __device__ __forceinline__ GAS const char* a_tile(const Unit& u) const { return A + (size_t)u.pm * tA; }
    __device__ __forceinline__ GAS const char* b_tile(const Unit& u) const { return Bt + (size_t)u.pn * tB; }
    __device__ __forceinline__ void ready(const Unit& u) const { if (cnt) { unsigned sp = 0;
        while ((unsigned)__builtin_amdgcn_readfirstlane((int)__hip_atomic_load(cnt + u.pm * 32, __ATOMIC_RELAXED, __HIP_MEMORY_SCOPE_AGENT)) < 8u) { __builtin_amdgcn_s_sleep(1); if (++sp > (1u << 22)) break; } } }
};
struct SchedZ {
    GAS const char* A; GAS const char* Bt; int G, c;
    __device__ __forceinline__ bool next(int i, Unit& u) const { const int L = i * G + c; if (L >= 1536 + 16) return false;
        if (L < 1536) pg8::std_order(L, 64, 24, u.pm, u.pn); else { const int q = L - 1536; u.pm = 64 + (q >> 2); u.pn = q & 3; } u.g = 0; return true; }
    __device__ __forceinline__ GAS const char* a_tile(const Unit& u) const { return A + (size_t)u.pm * (256 * D); }
    __device__ __forceinline__ GAS const char* b_tile(const Unit& u) const { return Bt + (size_t)u.pn * (256 * D); }
};
struct SchedS5a {
    GAS const char* US; GAS const char* EB; int G, c;
    __device__ __forceinline__ bool next(int i, Unit& u) const { const int L = i * G + c; if (L >= S5G * 3) return false; u.g = L / 3; u.pm = L % 3; u.pn = 0; return true; }
    __device__ __forceinline__ GAS const char* a_tile(const Unit& u) const { return US + ((size_t)u.g * CROWS + u.pm * 256) * (USLD * 2); }
    __device__ __forceinline__ GAS const char* b_tile(const Unit& u) const { return EB + (size_t)u.g * (256 * 512 * 2); }
};
struct SchedS5c {
    GAS const char* US; GAS const char* TB; int G, c;
    __device__ __forceinline__ bool next(int i, Unit& u) const { const int L = i * G + c; if (L >= S5G * 4) return false; u.g = L >> 2; u.pm = (L >> 1) & 1; u.pn = L & 1; return true; }
    __device__ __forceinline__ GAS const char* a_tile(const Unit& u) const { return US + ((size_t)u.g * CROWS + u.pm * 256) * (USLD * 2); }
    __device__ __forceinline__ GAS const char* b_tile(const Unit& u) const { return TB + ((size_t)u.g * 512 + u.pn * 256) * (768 * 2); }
};
struct SchedPool {
    GAS const char* PP; GAS const char* WP; int G, c;
    __device__ __forceinline__ bool next(int i, Unit& u) const { const int L = i * G + c; if (L >= 256) return false; u.pm = L >> 2; u.pn = L & 3; u.g = 0; return true; }
    __device__ __forceinline__ GAS const char* a_tile(const Unit& u) const { return PP + ((size_t)u.pm * 256 * 1024 + u.pn * 256) * 2; }
    __device__ __forceinline__ GAS const char* b_tile(const Unit& u) const { return WP + (size_t)u.pn * (256 * 256 * 2); }
};

__device__ __forceinline__ void st16_wt(GAS void* p, v4u w) { asm volatile("global_store_dwordx4 %0, %1, off sc1\n\ts_nop 1" :: "v"(p), "v"(w)); }
#define EPI_LOOP_AI_M for (int ai = 0; ai < 2; ++ai) _Pragma("unroll") for (int m = 0; m < 4; ++m)
struct EpiZ {
    static constexpr bool PERM = true, DUAL = false;
    GAS bf16* US; GAS bf16* ZP; GAS bf16* GATES; GAS const float* XNS; GAS const float* WSC;
    __device__ __forceinline__ void operator()(const f32x4 (&acc)[2][2][4][2], const Unit& u, int wr, int wc, int fr, int fq) const {
        f32x4 wsc[2][2]; float rsv[2][4];
#pragma unroll
        for (int bj = 0; bj < 2; ++bj) { const int col = u.pn * 256 + bj * 128 + wc * 32 + 8 * fq; wsc[bj][0] = *(GAS const f32x4*)(WSC + col); wsc[bj][1] = *(GAS const f32x4*)(WSC + col + 4); }
#pragma unroll
        for (int ai = 0; ai < 2; ++ai)
#pragma unroll
            for (int m = 0; m < 4; ++m) rsv[ai][m] = XNS[u.pm * 256 + ai * 128 + wr * 64 + m * 16 + fr];
#pragma unroll
        EPI_LOOP_AI_M {
            const int rl = ai * 128 + wr * 64 + m * 16 + fr;
            const float rs = rsv[ai][m];
#pragma unroll
            for (int bj = 0; bj < 2; ++bj) {
                const int col = u.pn * 256 + bj * 128 + wc * 32 + 8 * fq;
                const i32x4 i0 = __builtin_bit_cast(i32x4, acc[ai][bj][m][0]), i1 = __builtin_bit_cast(i32x4, acc[ai][bj][m][1]);
                const f32x4 s0 = wsc[bj][0] * rs, s1 = wsc[bj][1] * rs;
                f32x4 v0 = (f32x4){(float)i0.x, (float)i0.y, (float)i0.z, (float)i0.w} * s0, v1 = (f32x4){(float)i1.x, (float)i1.y, (float)i1.z, (float)i1.w} * s1;
                GAS bf16* dst;
                if (u.pn < 4) {
                    int crow, s;
                    if (u.pm < 64) { const int tok = u.pm * 256 + rl; const int b = tok >> 12, tp = tok & 4095; crow = b * NCHL + (tp >> 5); s = tp & 31; }
                    else { const int rc = (u.pm - 64) * 256 + rl; const int b = rc >> 8, tp = rc & 255; crow = 512 + b * NCHC + (tp >> 5); s = tp & 31; }
                    const int g = col >> 4, hh = col & 15;
                    dst = US + ((size_t)g * CROWS + crow) * USLD + s * 16 + hh;
                } else if (u.pn < 8) {
                    dst = ZP + (size_t)(u.pm * 256 + rl) * 1024 + (col - 1024);
                } else {
                    if (GATES_U8) {
                        unsigned t[8];
#pragma unroll
                        for (int j = 0; j < 4; ++j) {
                            const float e0 = __builtin_amdgcn_exp2f(v0[j] * -1.4426950408889634f), e1 = __builtin_amdgcn_exp2f(v1[j] * -1.4426950408889634f);
                            t[j] = __builtin_bit_cast(unsigned, __builtin_amdgcn_rcpf(__builtin_fmaf(e0, 1.0f / 255.0f, 1.0f / 255.0f)) + 8388608.0f);
                            t[4 + j] = __builtin_bit_cast(unsigned, __builtin_amdgcn_rcpf(__builtin_fmaf(e1, 1.0f / 255.0f, 1.0f / 255.0f)) + 8388608.0f); }
                        v2u w8;
                        w8.x = __builtin_amdgcn_perm(t[1], t[0], 0x0c0c0400u) | (__builtin_amdgcn_perm(t[3], t[2], 0x0c0c0400u) << 16);
                        w8.y = __builtin_amdgcn_perm(t[5], t[4], 0x0c0c0400u) | (__builtin_amdgcn_perm(t[7], t[6], 0x0c0c0400u) << 16);
                        *(GAS v2u*)((GAS unsigned char*)GATES + (size_t)(u.pm * 256 + rl) * 4096 + (col - 2048)) = w8;
                        continue;
                    }
#pragma unroll
                    for (int j = 0; j < 4; ++j) { v0[j] = sigmoidf_(v0[j]); v1[j] = sigmoidf_(v1[j]); }
                    dst = GATES + (size_t)(u.pm * 256 + rl) * 4096 + (col - 2048);
                }
                v4u w; w.x = pk2(v0[0], v0[1]); w.y = pk2(v0[2], v0[3]); w.z = pk2(v1[0], v1[1]); w.w = pk2(v1[2], v1[3]);
                *(GAS v4u*)dst = w;
            }
        }
    }
};
struct EpiHloc {
    static constexpr bool PERM = false, DUAL = false;
    GAS bf16* HL;
    __device__ __forceinline__ void operator()(const f32x4 (&acc)[2][2][4][2], const Unit& u, int wr, int wc, int fr, int fq) const {
#pragma unroll
        EPI_LOOP_AI_M {
            const int row = u.pm * 256 + ai * 128 + wr * 64 + m * 16 + fr;
            GAS bf16* rp = HL + ((size_t)u.g * CROWS + row) * 256 + wc * 32 + 4 * fq;
#pragma unroll
            for (int bj = 0; bj < 2; ++bj)
#pragma unroll
                for (int n = 0; n < 2; ++n) { const f32x4 a = acc[ai][bj][m][n]; v2u w; w.x = pk2(a.x, a.y); w.y = pk2(a.z, a.w); *(GAS v2u*)(rp + bj * 128 + n * 16) = w; }
        }
    }
};
struct EpiS5c {
    static constexpr bool PERM = true, DUAL = false;
    GAS const bf16* US; GAS bf16* G1; GAS const float* dskip; GAS const float* YN; unsigned* CTLW;
    __device__ __forceinline__ void operator()(const f32x4 (&acc)[2][2][4][2], const Unit& u, int wr, int wc, int fr, int fq) const {
        float dnum = 0.f, dden = 0.f;
        const int h0 = (8 * fq) & 15;
        const f32x4 d0 = *(GAS const f32x4*)(dskip + u.g * 16 + h0), d1 = *(GAS const f32x4*)(dskip + u.g * 16 + h0 + 4);
#pragma unroll
        for (int ai = 0; ai < 2; ++ai) {
        v4u uwv[4][2];
#pragma unroll
        for (int m = 0; m < 4; ++m)
#pragma unroll
            for (int bj = 0; bj < 2; ++bj) uwv[m][bj] = *(GAS const v4u*)(US + ((size_t)u.g * CROWS + u.pm * 256 + ai * 128 + wr * 64 + m * 16 + fr) * USLD + u.pn * 256 + bj * 128 + wc * 32 + 8 * fq);
#pragma unroll
        for (int m = 0; m < 4; ++m) {
            const int crow = u.pm * 256 + ai * 128 + wr * 64 + m * 16 + fr;
            const int b = crow >> 7, ch = crow & 127;
#pragma unroll
            for (int bj = 0; bj < 2; ++bj) {
                const int col = u.pn * 256 + bj * 128 + wc * 32 + 8 * fq;
                const int t = col >> 4;
                const v4u uw = uwv[m][bj];
                f32x4 v0 = acc[ai][bj][m][0], v1 = acc[ai][bj][m][1];
                if (DIAG == 5) { v0 = (f32x4){0.f, 0.f, 0.f, 0.f}; v1 = v0; }
                if (DIAG == 6) { v0 = -v0; v1 = -v1; }
                if (DIAG == 10 || DIAG == 11) { GAS const float* yn = YN + ((size_t)b * SEQ + ch * TCH + t) * S5W + u.g * 16 + h0; const f32x4 r0 = *(GAS const f32x4*)yn, r1 = *(GAS const f32x4*)(yn + 4);
                    const f32x4 e0 = v0 - r0, e1 = v1 - r1; dnum += e0.x * e0.x + e0.y * e0.y + e0.z * e0.z + e0.w * e0.w + e1.x * e1.x + e1.y * e1.y + e1.z * e1.z + e1.w * e1.w; dden += r0.x * r0.x + r0.y * r0.y + r0.z * r0.z + r0.w * r0.w + r1.x * r1.x + r1.y * r1.y + r1.z * r1.z + r1.w * r1.w; }
                float o[8];
                o[0] = v0[0] + d0[0] * bflo(uw.x); o[1] = v0[1] + d0[1] * bfhi(uw.x); o[2] = v0[2] + d0[2] * bflo(uw.y); o[3] = v0[3] + d0[3] * bfhi(uw.y);
                o[4] = v1[0] + d1[0] * bflo(uw.z); o[5] = v1[1] + d1[1] * bfhi(uw.z); o[6] = v1[2] + d1[2] * bflo(uw.w); o[7] = v1[3] + d1[3] * bfhi(uw.w);
#pragma unroll
                for (int j = 0; j < 8; ++j) o[j] = gelu_tanh(o[j]);
                const size_t tok = (size_t)b * SEQ + ch * TCH + t;
                v4u w; w.x = pk2(o[0], o[1]); w.y = pk2(o[2], o[3]); w.z = pk2(o[4], o[5]); w.w = pk2(o[6], o[7]);
                *(GAS v4u*)(G1 + tok * S5W + u.g * 16 + h0) = w;
            }
        }
        asm volatile("" ::: "memory");
        }
        if (DIAG == 10 || DIAG == 11) { dnum = wave_sum(dnum); dden = wave_sum(dden); if ((threadIdx.x & 63) == 0) { atomicAdd((float*)CTLW + CW_DNUM, dnum); atomicAdd((float*)CTLW + CW_DDEN, dden); } }
    }
};
struct EpiPool {
    static constexpr bool PERM = true, DUAL = false;
    GAS bf16* YB; GAS const float* scale;
    __device__ __forceinline__ void operator()(const f32x4 (&acc)[2][2][4][2], const Unit& u, int wr, int wc, int fr, int fq) const {
        f32x4 sv[2][2];
#pragma unroll
        for (int bj = 0; bj < 2; ++bj) { const int col = u.pn * 256 + bj * 128 + wc * 32 + 8 * fq; sv[bj][0] = *(GAS const f32x4*)(scale + col); sv[bj][1] = *(GAS const f32x4*)(scale + col + 4); }
#pragma unroll
        EPI_LOOP_AI_M {
            const int row = u.pm * 256 + ai * 128 + wr * 64 + m * 16 + fr;
#pragma unroll
            for (int bj = 0; bj < 2; ++bj) {
                const int col = u.pn * 256 + bj * 128 + wc * 32 + 8 * fq;
                const f32x4 v0 = acc[ai][bj][m][0] * sv[bj][0], v1 = acc[ai][bj][m][1] * sv[bj][1];
                v4u w; w.x = pk2(v0[0], v0[1]); w.y = pk2(v0[2], v0[3]); w.z = pk2(v1[0], v1[1]); w.w = pk2(v1[2], v1[3]);
                *(GAS v4u*)(YB + (size_t)row * 1024 + col) = w;
            }
        }
    }
};
struct EpiGlu {
    static constexpr bool PERM = true, DUAL = false;
    GAS const bf16* G1; GAS bf16* YA; GAS const float* bias;
    __device__ __forceinline__ void operator()(const f32x4 (&acc)[2][2][4][2], const Unit& u, int wr, int wc, int fr, int fq) const {
        f32x4 bv[2][2];
#pragma unroll
        for (int bj = 0; bj < 2; ++bj) { const int col = u.pn * 256 + bj * 128 + wc * 32 + 8 * fq; bv[bj][0] = *(GAS const f32x4*)(bias + col); bv[bj][1] = *(GAS const f32x4*)(bias + col + 4); }
#pragma unroll
        for (int ai = 0; ai < 2; ++ai) {
            v4u gv[4][2];
#pragma unroll
            for (int m = 0; m < 4; ++m)
#pragma unroll
                for (int bj = 0; bj < 2; ++bj) gv[m][bj] = *(GAS const v4u*)(G1 + (size_t)(u.pm * 256 + ai * 128 + wr * 64 + m * 16 + fr) * 1024 + u.pn * 256 + bj * 128 + wc * 32 + 8 * fq);
#pragma unroll
            for (int m = 0; m < 4; ++m) {
                const int row = u.pm * 256 + ai * 128 + wr * 64 + m * 16 + fr;
#pragma unroll
                for (int bj = 0; bj < 2; ++bj) {
                    const int col = u.pn * 256 + bj * 128 + wc * 32 + 8 * fq;
                    const v4u gw = gv[m][bj];
                    const f32x4 v0 = acc[ai][bj][m][0] + bv[bj][0], v1 = acc[ai][bj][m][1] + bv[bj][1];
                    float o[8];
                    o[0] = bflo(gw.x) * sigmoidf_(v0[0]); o[1] = bfhi(gw.x) * sigmoidf_(v0[1]); o[2] = bflo(gw.y) * sigmoidf_(v0[2]); o[3] = bfhi(gw.y) * sigmoidf_(v0[3]);
                    o[4] = bflo(gw.z) * sigmoidf_(v1[0]); o[5] = bfhi(gw.z) * sigmoidf_(v1[1]); o[6] = bflo(gw.w) * sigmoidf_(v1[2]); o[7] = bfhi(gw.w) * sigmoidf_(v1[3]);
                    v4u w; w.x = pk2(o[0], o[1]); w.y = pk2(o[2], o[3]); w.z = pk2(o[4], o[5]); w.w = pk2(o[6], o[7]);
                    if (MERGE_CHAIN) st16_wt(YA + (size_t)row * 1024 + col, w); else *(GAS v4u*)(YA + (size_t)row * 1024 + col) = w;
                }
            }
            asm volatile("" ::: "memory");
        }
    }
};
template <int MODE> struct EpiMerge {
    static constexpr bool PERM = true, DUAL = false;
    GAS const bf16* GATES; GAS const bf16* T1in; GAS bf16* OUT;
    __device__ __forceinline__ void operator()(const f32x4 (&acc)[2][2][4][2], const Unit& u, int wr, int wc, int fr, int fq) const {
#pragma unroll
        EPI_LOOP_AI_M {
            const int row = u.pm * 256 + ai * 128 + wr * 64 + m * 16 + fr;
#pragma unroll
            for (int bj = 0; bj < 2; ++bj) {
                const int col = u.pn * 256 + bj * 128 + wc * 32 + 8 * fq;
                const v4u gt = *(GAS const v4u*)(GATES + (size_t)row * 4096 + MODE * 2048 + col);
                const f32x4 v0 = acc[ai][bj][m][0], v1 = acc[ai][bj][m][1];
                float o[8];
                o[0] = bflo(gt.x) * v0[0]; o[1] = bfhi(gt.x) * v0[1]; o[2] = bflo(gt.y) * v0[2]; o[3] = bfhi(gt.y) * v0[3];
                o[4] = bflo(gt.z) * v1[0]; o[5] = bfhi(gt.z) * v1[1]; o[6] = bflo(gt.w) * v1[2]; o[7] = bfhi(gt.w) * v1[3];
                if (MODE == 1) {
                    const v4u tw = *(GAS const v4u*)(T1in + (size_t)row * 2048 + col);
                    o[0] += bflo(tw.x); o[1] += bfhi(tw.x); o[2] += bflo(tw.y); o[3] += bfhi(tw.y); o[4] += bflo(tw.z); o[5] += bfhi(tw.z); o[6] += bflo(tw.w); o[7] += bfhi(tw.w);
                }
                v4u w; w.x = pk2(o[0], o[1]); w.y = pk2(o[2], o[3]); w.z = pk2(o[4], o[5]); w.w = pk2(o[6], o[7]);
                *(GAS v4u*)(OUT + (size_t)row * 2048 + col) = w;
                asm volatile("" ::: "memory");
            }
        }
    }
};

static_assert(!MERGE_CHAIN || GATES_U8, "the chained merge uses the unorm8 gate path");
struct EpiMerge2 {
    static constexpr bool PERM = true, DUAL = true;
    GAS const bf16* GATES; GAS bf16* OUT;
    __device__ __forceinline__ void mid(f32x4 (&acc)[2][2][4][2], const Unit& u, int wr, int wc, int fr, int fq) const {
#define GBC(x) fmaxf((x), 1e-30f)
#define UB(w, k) ((float)(((w) >> (8 * (k))) & 0xffu))
        if (GATES_U8) {
            v2u gav[2][4][2], gbv[2][4][2];
#pragma unroll
            for (int ai = 0; ai < 2; ++ai)
#pragma unroll
                for (int m = 0; m < 4; ++m)
#pragma unroll
                    for (int bj = 0; bj < 2; ++bj) { GAS const unsigned char* gp = (GAS const unsigned char*)GATES + (size_t)(u.pm * 256 + ai * 128 + wr * 64 + m * 16 + fr) * 4096 + u.pn * 256 + bj * 128 + wc * 32 + 8 * fq;
                        gav[ai][m][bj] = *(GAS const v2u*)(gp + (MERGE_CHAIN ? 2048 : 0)); gbv[ai][m][bj] = *(GAS const v2u*)(gp + (MERGE_CHAIN ? 0 : 2048)); }
#pragma unroll
            for (int ai = 0; ai < 2; ++ai)
#pragma unroll
                for (int m = 0; m < 4; ++m)
#pragma unroll
                    for (int bj = 0; bj < 2; ++bj) { const v2u ga = gav[ai][m][bj], gb = gbv[ai][m][bj]; const float k = 1.0f / 255.0f;
                        f32x4 r0, r1;
#pragma unroll
                        for (int e = 0; e < 4; ++e) { r0[e] = (UB(ga.x, e) * k) * __builtin_amdgcn_rcpf(GBC(UB(gb.x, e) * k)); r1[e] = (UB(ga.y, e) * k) * __builtin_amdgcn_rcpf(GBC(UB(gb.y, e) * k)); }
                        acc[ai][bj][m][0] *= r0; acc[ai][bj][m][1] *= r1; }
            asm volatile("" ::: "memory");
            return;
        }
#pragma unroll
        for (int ai = 0; ai < 2; ++ai) {
            v4u gav[4][2], gbv[4][2];
#pragma unroll
            for (int m = 0; m < 4; ++m)
#pragma unroll
                for (int bj = 0; bj < 2; ++bj) { GAS const bf16* gp = GATES + (size_t)(u.pm * 256 + ai * 128 + wr * 64 + m * 16 + fr) * 4096 + u.pn * 256 + bj * 128 + wc * 32 + 8 * fq;
                    gav[m][bj] = *(GAS const v4u*)gp; gbv[m][bj] = *(GAS const v4u*)(gp + 2048); }
#pragma unroll
            for (int m = 0; m < 4; ++m)
#pragma unroll
                for (int bj = 0; bj < 2; ++bj) { const v4u ga = gav[m][bj], gb = gbv[m][bj];
                    f32x4 r0, r1;
                    r0[0] = bflo(ga.x) * __builtin_amdgcn_rcpf(GBC(bflo(gb.x))); r0[1] = bfhi(ga.x) * __builtin_amdgcn_rcpf(GBC(bfhi(gb.x))); r0[2] = bflo(ga.y) * __builtin_amdgcn_rcpf(GBC(bflo(gb.y))); r0[3] = bfhi(ga.y) * __builtin_amdgcn_rcpf(GBC(bfhi(gb.y)));
                    r1[0] = bflo(ga.z) * __builtin_amdgcn_rcpf(GBC(bflo(gb.z))); r1[1] = bfhi(ga.z) * __builtin_amdgcn_rcpf(GBC(bfhi(gb.z))); r1[2] = bflo(ga.w) * __builtin_amdgcn_rcpf(GBC(bflo(gb.w))); r1[3] = bfhi(ga.w) * __builtin_amdgcn_rcpf(GBC(bfhi(gb.w)));
                    acc[ai][bj][m][0] *= r0; acc[ai][bj][m][1] *= r1; }
            asm volatile("" ::: "memory");
        }
    }
    __device__ __forceinline__ void operator()(const f32x4 (&acc)[2][2][4][2], const Unit& u, int wr, int wc, int fr, int fq) const {
        if (GATES_U8) {
            v2u gbv[2][4][2];
#pragma unroll
            for (int ai = 0; ai < 2; ++ai)
#pragma unroll
                for (int m = 0; m < 4; ++m)
#pragma unroll
                    for (int bj = 0; bj < 2; ++bj) gbv[ai][m][bj] = *(GAS const v2u*)((GAS const unsigned char*)GATES + (size_t)(u.pm * 256 + ai * 128 + wr * 64 + m * 16 + fr) * 4096 + (MERGE_CHAIN ? 0 : 2048) + u.pn * 256 + bj * 128 + wc * 32 + 8 * fq);
#pragma unroll
            for (int ai = 0; ai < 2; ++ai)
#pragma unroll
                for (int m = 0; m < 4; ++m) {
                    const int row = u.pm * 256 + ai * 128 + wr * 64 + m * 16 + fr;
#pragma unroll
                    for (int bj = 0; bj < 2; ++bj) {
                        const int col = u.pn * 256 + bj * 128 + wc * 32 + 8 * fq;
                        const v2u gt = gbv[ai][m][bj]; const float k = 1.0f / 255.0f;
                        const f32x4 v0 = acc[ai][bj][m][0], v1 = acc[ai][bj][m][1];
                        v4u w; w.x = pk2(GBC(UB(gt.x, 0) * k) * v0[0], GBC(UB(gt.x, 1) * k) * v0[1]); w.y = pk2(GBC(UB(gt.x, 2) * k) * v0[2], GBC(UB(gt.x, 3) * k) * v0[3]);
                        w.z = pk2(GBC(UB(gt.y, 0) * k) * v1[0], GBC(UB(gt.y, 1) * k) * v1[1]); w.w = pk2(GBC(UB(gt.y, 2) * k) * v1[2], GBC(UB(gt.y, 3) * k) * v1[3]);
                        if (WOUT_CHAIN) st16_wt(OUT + (size_t)row * 2048 + col, w); else *(GAS v4u*)(OUT + (size_t)row * 2048 + col) = w;
                    }
                }
            return;
        }
#pragma unroll
        for (int ai = 0; ai < 2; ++ai) {
            v4u gbv[4][2];
#pragma unroll
            for (int m = 0; m < 4; ++m)
#pragma unroll
                for (int bj = 0; bj < 2; ++bj) gbv[m][bj] = *(GAS const v4u*)(GATES + (size_t)(u.pm * 256 + ai * 128 + wr * 64 + m * 16 + fr) * 4096 + 2048 + u.pn * 256 + bj * 128 + wc * 32 + 8 * fq);
#pragma unroll
            for (int m = 0; m < 4; ++m) {
                const int row = u.pm * 256 + ai * 128 + wr * 64 + m * 16 + fr;
#pragma unroll
                for (int bj = 0; bj < 2; ++bj) {
                    const int col = u.pn * 256 + bj * 128 + wc * 32 + 8 * fq;
                    const v4u gt = gbv[m][bj];
                    const f32x4 v0 = acc[ai][bj][m][0], v1 = acc[ai][bj][m][1];
                    v4u w; w.x = pk2(GBC(bflo(gt.x)) * v0[0], GBC(bfhi(gt.x)) * v0[1]); w.y = pk2(GBC(bflo(gt.y)) * v0[2], GBC(bfhi(gt.y)) * v0[3]); w.z = pk2(GBC(bflo(gt.z)) * v1[0], GBC(bfhi(gt.z)) * v1[1]); w.w = pk2(GBC(bflo(gt.w)) * v1[2], GBC(bfhi(gt.w)) * v1[3]);
                    *(GAS v4u*)(OUT + (size_t)row * 2048 + col) = w;
                }
            }
            asm volatile("" ::: "memory");
        }
    }
};
struct SchedMerge {
    GAS const char* YA; GAS const char* YB; GAS const char* PA; GAS const char* PB; int G, c; GAS unsigned* cnt;
    __device__ __forceinline__ bool next(int i, Unit& u) const { const int L = (i >> 1) * G + c; if (L >= 512) return false; pg8::std_order(L, 64, 8, u.pm, u.pn); u.g = i & 1; return true; }
    __device__ __forceinline__ GAS const char* a_tile(const Unit& u) const { return ((u.g != 0) == (MERGE_CHAIN != 0) ? YA : YB) + (size_t)u.pm * (256 * 1024 * 2); }
    __device__ __forceinline__ GAS const char* b_tile(const Unit& u) const { return ((u.g != 0) == (MERGE_CHAIN != 0) ? PA : PB) + (size_t)u.pn * (256 * 1024 * 2); }
    __device__ __forceinline__ void ready(const Unit& u) const {
        if (MERGE_CHAIN && u.g == 1) { unsigned sp = 0;
            while ((unsigned)__builtin_amdgcn_readfirstlane((int)__hip_atomic_load(cnt + u.pm * 32, __ATOMIC_RELAXED, __HIP_MEMORY_SCOPE_AGENT)) < 4u) { __builtin_amdgcn_s_sleep(1); if (++sp > (1u << 22)) break; } }
    }
};
struct EpiWout {
    static constexpr bool PERM = true, DUAL = false;
    GAS bf16* D1; GAS const float* MOD; GAS const float* X;
    __device__ __forceinline__ void operator()(const f32x4 (&acc)[2][2][4][2], const Unit& u, int wr, int wc, int fr, int fq) const {
        const int b = u.pm >> 4;
        GAS const float* g1 = MOD + (size_t)b * NMOD + 2 * D;
        f32x4 g1v[2][2];
#pragma unroll
        for (int bj = 0; bj < 2; ++bj) { const int col = u.pn * 256 + bj * 128 + wc * 32 + 8 * fq; g1v[bj][0] = *(GAS const f32x4*)(g1 + col); g1v[bj][1] = *(GAS const f32x4*)(g1 + col + 4); }
#pragma unroll
        for (int ai = 0; ai < 2; ++ai) {
            f32x4 xv[4][2][2];
            if (XR_EPI) {
#pragma unroll
                for (int m = 0; m < 4; ++m)
#pragma unroll
                    for (int bj = 0; bj < 2; ++bj) { GAS const float* xp = X + (size_t)(u.pm * 256 + ai * 128 + wr * 64 + m * 16 + fr) * D + u.pn * 256 + bj * 128 + wc * 32 + 8 * fq;
                        xv[m][bj][0] = *(GAS const f32x4*)xp; xv[m][bj][1] = *(GAS const f32x4*)(xp + 4); }
            }
#pragma unroll
            for (int m = 0; m < 4; ++m) {
                const int row = u.pm * 256 + ai * 128 + wr * 64 + m * 16 + fr;
#pragma unroll
                for (int bj = 0; bj < 2; ++bj) {
                    const int col = u.pn * 256 + bj * 128 + wc * 32 + 8 * fq;
                    f32x4 v0 = acc[ai][bj][m][0] * g1v[bj][0], v1 = acc[ai][bj][m][1] * g1v[bj][1];
                    if (XR_EPI) { v0 += xv[m][bj][0]; v1 += xv[m][bj][1]; }
                    v4u w; w.x = pk2(v0[0], v0[1]); w.y = pk2(v0[2], v0[3]); w.z = pk2(v1[0], v1[1]); w.w = pk2(v1[2], v1[3]);
                    *(GAS v4u*)(D1 + (size_t)row * D + col) = w;
                }
            }
        }
    }
};
struct EpiQ {
    static constexpr bool PERM = true, DUAL = false;
    GAS bf16* Q;
    __device__ __forceinline__ void operator()(const f32x4 (&acc)[2][2][4][2], const Unit& u, int wr, int wc, int fr, int fq) const {
#pragma unroll
        EPI_LOOP_AI_M {
            const int row = u.pm * 256 + ai * 128 + wr * 64 + m * 16 + fr;
#pragma unroll
            for (int bj = 0; bj < 2; ++bj) {
                const int col = u.pn * 256 + bj * 128 + wc * 32 + 8 * fq;
                const f32x4 v0 = acc[ai][bj][m][0], v1 = acc[ai][bj][m][1];
                v4u w; w.x = pk2(v0[0], v0[1]); w.y = pk2(v0[2], v0[3]); w.z = pk2(v1[0], v1[1]); w.w = pk2(v1[2], v1[3]);
                *(GAS v4u*)(Q + (size_t)row * D + col) = w;
            }
        }
    }
};

struct EpiQ8 {
    static constexpr bool PERM = true, DUAL = false;
    GAS bf16* Q; GAS const float* HSC; GAS const float* WQSC;
    __device__ __forceinline__ void operator()(const f32x4 (&acc)[2][2][4][2], const Unit& u, int wr, int wc, int fr, int fq) const {
        f32x4 wsc[2][2]; float rsv[2][4];
#pragma unroll
        for (int bj = 0; bj < 2; ++bj) { const int col = u.pn * 256 + bj * 128 + wc * 32 + 8 * fq; wsc[bj][0] = *(GAS const f32x4*)(WQSC + col); wsc[bj][1] = *(GAS const f32x4*)(WQSC + col + 4); }
#pragma unroll
        for (int ai = 0; ai < 2; ++ai)
#pragma unroll
            for (int m = 0; m < 4; ++m) rsv[ai][m] = HSC[u.pm * 256 + ai * 128 + wr * 64 + m * 16 + fr];
#pragma unroll
        EPI_LOOP_AI_M {
            const int row = u.pm * 256 + ai * 128 + wr * 64 + m * 16 + fr;
            const float rs = rsv[ai][m];
#pragma unroll
            for (int bj = 0; bj < 2; ++bj) {
                const int col = u.pn * 256 + bj * 128 + wc * 32 + 8 * fq;
                const i32x4 i0 = __builtin_bit_cast(i32x4, acc[ai][bj][m][0]), i1 = __builtin_bit_cast(i32x4, acc[ai][bj][m][1]);
                const f32x4 s0 = wsc[bj][0] * rs, s1 = wsc[bj][1] * rs;
                const f32x4 v0 = (f32x4){(float)i0.x, (float)i0.y, (float)i0.z, (float)i0.w} * s0, v1 = (f32x4){(float)i1.x, (float)i1.y, (float)i1.z, (float)i1.w} * s1;
                v4u w; w.x = pk2(v0[0], v0[1]); w.y = pk2(v0[2], v0[3]); w.z = pk2(v1[0], v1[1]); w.w = pk2(v1[2], v1[3]);
                *(GAS v4u*)(Q + (size_t)row * D + col) = w;
            }
        }
    }
};

__device__ __forceinline__ void s5_tables(Frame& F, int g, const int part, const int nparts, const int nrep_c = 1, const int nrep_w = 1, const int nown = 1) {
    LAS float* APW = (LAS float*)F.lds;
    LAS float* BB = APW + 2 * 33 * 64 * 2;
    LAS float* CC = BB + 2 * 64 * 16 * 2;
    LAS float* KC = CC + 2 * 16 * 64 * 2;
    GAS const float* a_re = F.inp(9); GAS const float* a_im = F.inp(10); GAS const float* log_dt = F.inp(11);
    GAS const float* b_re = F.inp(12); GAS const float* b_im = F.inp(13); GAS const float* c_re = F.inp(14); GAS const float* c_im = F.inp(15);
    for (int rc = 0; rc < nrep_c; ++rc) {
    if (F.tid < 128) {
        const int p = F.tid & 63, dir = F.tid >> 6;
        const float dt = expf(log_dt[dir * 64 + g]);
        const float ar = a_re[(dir * 64 + g) * 64 + p], ai = a_im[(dir * 64 + g) * 64 + p];
        const float mag = expf(dt * ar); float sn, cs; sincosf(dt * ai, &sn, &cs);
        const float a1r = mag * cs, a1i = mag * sn;
        float zr = 1.0f, zi = 0.0f;
        for (int j = 0; j <= 32; ++j) { APW[((dir * 33 + j) * 64 + p) * 2] = zr; APW[((dir * 33 + j) * 64 + p) * 2 + 1] = zi; const float nr = zr * a1r - zi * a1i, ni = zr * a1i + zi * a1r; zr = nr; zi = ni; }
    }
    __syncthreads();
    for (int idx = F.tid; idx < 2 * 64 * 16; idx += 512) {
        const int hp = idx & 15, p = (idx >> 4) & 63, dir = idx >> 10;
        const float ar = a_re[(dir * 64 + g) * 64 + p], ai = a_im[(dir * 64 + g) * 64 + p];
        const float a1r = APW[((dir * 33 + 1) * 64 + p) * 2], a1i = APW[((dir * 33 + 1) * 64 + p) * 2 + 1];
        const float nr = a1r - 1.0f, ni = a1i, den = ar * ar + ai * ai;
        const float fre = (nr * ar + ni * ai) / den, fim = (ni * ar - nr * ai) / den;
        const float br = b_re[((size_t)(dir * 64 + g) * 64 + p) * 16 + hp], bi = b_im[((size_t)(dir * 64 + g) * 64 + p) * 16 + hp];
        BB[idx * 2] = fre * br - fim * bi; BB[idx * 2 + 1] = fre * bi + fim * br;
    }
    for (int idx = F.tid; idx < 2 * 16 * 64; idx += 512) {
        const int p = idx & 63, h = (idx >> 6) & 15, dir = idx >> 10;
        CC[idx * 2] = c_re[((size_t)(dir * 64 + g) * 16 + h) * 64 + p]; CC[idx * 2 + 1] = c_im[((size_t)(dir * 64 + g) * 16 + h) * 64 + p];
    }
    __syncthreads();
    {
        const int hp = F.tid & 15, h = (F.tid >> 4) & 15, dir = F.tid >> 8;
        LAS float* kc = KC + ((dir * 16 + h) * 16 + hp) * 33;
#pragma unroll 1
        for (int pb = 0; pb < 64; pb += 16) {
            float zr[16], zi[16];
#pragma unroll
            for (int q = 0; q < 16; ++q) { const int p = pb + q;
                const float cr = CC[((dir * 16 + h) * 64 + p) * 2], ci = CC[((dir * 16 + h) * 64 + p) * 2 + 1];
                const float br = BB[((dir * 64 + p) * 16 + hp) * 2], bi = BB[((dir * 64 + p) * 16 + hp) * 2 + 1];
                zr[q] = cr * br - ci * bi; zi[q] = cr * bi + ci * br; }
            const int jmax = nparts == 4 ? (dir == 0 ? 8 * (part + nown - 1) + 8 : 32 - 8 * part) : 32;
#pragma unroll 1
            for (int j = 0; j < jmax; ++j) {
                const LAS f32x4* ap = (const LAS f32x4*)(APW + ((dir * 33 + j) * 64 + pb) * 2);
                float sr = 0.f;
#pragma unroll
                for (int q2 = 0; q2 < 8; ++q2) { const f32x4 a = ap[q2]; sr += a.x * zr[2 * q2] - a.y * zi[2 * q2] + a.z * zr[2 * q2 + 1] - a.w * zi[2 * q2 + 1]; }
                kc[j] = (pb == 0) ? sr : kc[j] + sr;
            }
        }
    }
    __syncthreads();
    }
    for (int rw = 0; rw < nrep_w; ++rw) {
    GAS bf16* TB = (GAS bf16*)(F.ws + WS_D) + (size_t)g * 512 * 768;
    for (int ck = (512 / nparts) * part * 96 + F.tid; ck < (512 / nparts) * (part + nown) * 96; ck += 512) {
        const int n = ck / 96, kc = ck % 96, k0 = kc * 8, t = n >> 4, h = n & 15;
        float v[8];
        if (k0 < 512) {
            const int s = k0 >> 4, h0 = k0 & 15;
#pragma unroll
            for (int i = 0; i < 8; ++i) { float x = 0.f;
                if (s <= t) x += KC[((0 * 16 + h) * 16 + h0 + i) * 33 + (t - s)];
                if (s >= t) x += KC[((1 * 16 + h) * 16 + h0 + i) * 33 + (s - t)];
                v[i] = x; }
        } else {
            const int part = (k0 - 512) >> 6, p0 = (k0 - 512) & 63, dir = part >> 1, pw = dir == 0 ? t + 1 : 32 - t;
#pragma unroll
            for (int i2 = 0; i2 < 4; ++i2) { const int p = p0 + 2 * i2;
                const f32x4 c2 = *(const LAS f32x4*)(CC + ((dir * 16 + h) * 64 + p) * 2), a2 = *(const LAS f32x4*)(APW + ((dir * 33 + pw) * 64 + p) * 2);
                v[2 * i2] = (part & 1) ? -(c2.x * a2.y + c2.y * a2.x) : (c2.x * a2.x - c2.y * a2.y);
                v[2 * i2 + 1] = (part & 1) ? -(c2.z * a2.w + c2.w * a2.z) : (c2.z * a2.z - c2.w * a2.w); }
        }
        v4u w; w.x = pk2(v[0], v[1]); w.y = pk2(v[2], v[3]); w.z = pk2(v[4], v[5]); w.w = pk2(v[6], v[7]);
        *(GAS v4u*)(TB + (size_t)n * 768 + k0) = w;
    }
    GAS bf16* EB = (GAS bf16*)(F.ws + WS_E) + (size_t)g * 256 * 512;
    for (int ck = (256 / nparts) * part * 64 + F.tid; ck < (256 / nparts) * (part + nown) * 64; ck += 512) {
        const int n = ck >> 6, kc = ck & 63, k0 = kc * 8, s = k0 >> 4, h0 = k0 & 15;
        const int part = n >> 6, p = n & 63, dir = part >> 1, pw = dir == 0 ? 31 - s : s;
        const float pr = APW[((dir * 33 + pw) * 64 + p) * 2], pi = APW[((dir * 33 + pw) * 64 + p) * 2 + 1];
        float v[8];
#pragma unroll
        for (int i = 0; i < 8; ++i) { const float br = BB[((dir * 64 + p) * 16 + h0 + i) * 2], bi = BB[((dir * 64 + p) * 16 + h0 + i) * 2 + 1];
            v[i] = (part & 1) ? (pr * bi + pi * br) : (pr * br - pi * bi); }
        v4u w; w.x = pk2(v[0], v[1]); w.y = pk2(v[2], v[3]); w.z = pk2(v[4], v[5]); w.w = pk2(v[6], v[7]);
        *(GAS v4u*)(EB + (size_t)n * 512 + k0) = w;
    }
    }
    __syncthreads();
}
__device__ __forceinline__ void mod_partials(Frame& F, int blk, int nblk) {
    LAS float* SV = (LAS float*)F.lds;
    GAS const float* c = F.inp(1); GAS const float* cctx = F.inp(3); GAS const float* W = F.inp(4);
    for (int idx = F.tid; idx < 5 * D; idx += 512) { const int r = idx >> 11, k = idx & 2047; const float v = r < 4 ? c[r * D + k] : cctx[k]; SV[idx] = v * sigmoidf_(v); }
    __syncthreads();
    GAS float* MODP = (GAS float*)(F.ws + WS_MODP);
    for (int item = blk * NWAVES + F.wave; item < 48 * KS_MOD; item += nblk * NWAVES) {
        const int cg = item % 48, ks = item / 48, col = cg * 256 + F.lane * 4, kbeg = ks * (D / KS_MOD);
        f32x4 a0 = {0.f, 0.f, 0.f, 0.f}, a1 = a0, a2 = a0, a3 = a0, a4 = a0;
        for (int k0 = 0; k0 < D / KS_MOD; k0 += 8) {
            f32x4 w[8];
#pragma unroll
            for (int kk = 0; kk < 8; ++kk) w[kk] = *(GAS const f32x4*)(W + (size_t)(kbeg + k0 + kk) * NMOD + col);
#pragma unroll
            for (int kk = 0; kk < 8; ++kk) { const int k = kbeg + k0 + kk;
                a0 += SV[k] * w[kk]; a1 += SV[D + k] * w[kk]; a2 += SV[2 * D + k] * w[kk]; a3 += SV[3 * D + k] * w[kk]; a4 += SV[4 * D + k] * w[kk]; }
        }
        GAS float* o = MODP + (size_t)ks * 5 * NMOD + col;
        *(GAS f32x4*)(o) = a0; *(GAS f32x4*)(o + NMOD) = a1; *(GAS f32x4*)(o + 2 * NMOD) = a2; *(GAS f32x4*)(o + 3 * NMOD) = a3; *(GAS f32x4*)(o + 4 * NMOD) = a4;
    }
    __syncthreads();
}
__device__ __forceinline__ void mod_full(Frame& F, int blk) {
    LAS float* SV = (LAS float*)F.lds;
    LAS float* PR = SV + 5 * D;
    GAS const float* c = F.inp(1); GAS const float* cctx = F.inp(3); GAS const float* W = F.inp(4);
    for (int idx = F.tid; idx < 5 * D; idx += 512) { const int r = idx >> 11, k = idx & 2047; const float v = r < 4 ? c[r * D + k] : cctx[k]; SV[idx] = v * sigmoidf_(v); }
    __syncthreads();
    const int l = F.lane, r2 = l >= 24 ? 1 : 0, cl = l - 24 * r2;
    if (l < 48) {
        f32x4 a0 = {0.f, 0.f, 0.f, 0.f}, a1 = a0, a2 = a0, a3 = a0, a4 = a0;
        GAS const float* wp = W + (size_t)(F.wave * 256 + r2) * NMOD + blk * 96 + cl * 4;
        for (int k0 = 0; k0 < 256; k0 += 32) {
            f32x4 w[16];
#pragma unroll
            for (int kk = 0; kk < 16; ++kk) w[kk] = *(GAS const f32x4*)(wp + (size_t)(k0 + 2 * kk) * NMOD);
#pragma unroll
            for (int kk = 0; kk < 16; ++kk) { const int k = F.wave * 256 + k0 + 2 * kk + r2;
                a0 += SV[k] * w[kk]; a1 += SV[D + k] * w[kk]; a2 += SV[2 * D + k] * w[kk]; a3 += SV[3 * D + k] * w[kk]; a4 += SV[4 * D + k] * w[kk]; }
        }
        LAS f32x4* pr = (LAS f32x4*)(PR + (F.wave * 48 + l) * 20);
        pr[0] = a0; pr[1] = a1; pr[2] = a2; pr[3] = a3; pr[4] = a4;
    }
    __syncthreads();
    if (F.tid < 480) { const int r = F.tid / 96, cc = F.tid % 96, cq = cc >> 2, i = cc & 3;
        float sacc = F.inp(5)[blk * 96 + cc];
#pragma unroll
        for (int w = 0; w < 8; ++w) sacc += PR[(w * 48 + cq) * 20 + r * 4 + i] + PR[(w * 48 + 24 + cq) * 20 + r * 4 + i];
        __hip_atomic_store((GAS float*)(F.ws + WS_MOD) + (size_t)r * NMOD + blk * 96 + cc, sacc, __ATOMIC_RELAXED, __HIP_MEMORY_SCOPE_AGENT); }
    asm volatile("s_waitcnt vmcnt(0)" ::: "memory");
    __syncthreads();
    if (F.tid == 0) __hip_atomic_fetch_add((unsigned*)(F.ws + WS_CTL) + CW_MODRDY, 1u, __ATOMIC_RELAXED, __HIP_MEMORY_SCOPE_AGENT);
}
__device__ __forceinline__ void transpose_item(GAS const float* W, int K, int N, GAS bf16* WT, LAS float* scr, int item, int lane) {
    const int nblk = N / 32, kb = item / nblk, nb = item % nblk, k0 = 64 * kb, n0 = 32 * nb;
    f32x4 tv[8];
#pragma unroll
    for (int i = 0; i < 8; ++i) { const int kk = 8 * i + (lane >> 3); tv[i] = *(GAS const f32x4*)(W + (size_t)(k0 + kk) * N + n0 + 4 * (lane & 7)); }
#pragma unroll
    for (int i = 0; i < 8; ++i) { const int kk = 8 * i + (lane >> 3); LAS float* sp = scr + kk * 33 + 4 * (lane & 7); sp[0] = tv[i].x; sp[1] = tv[i].y; sp[2] = tv[i].z; sp[3] = tv[i].w; }
    LDS_WAIT(); asm volatile("" ::: "memory");
    const int c = lane & 7;
#pragma unroll
    for (int j = 0; j < 4; ++j) { const int n = (lane >> 3) + 8 * j; const LAS float* s = scr + (8 * c) * 33 + n;
        v4u o; o.x = pk2(s[0 * 33], s[1 * 33]); o.y = pk2(s[2 * 33], s[3 * 33]); o.z = pk2(s[4 * 33], s[5 * 33]); o.w = pk2(s[6 * 33], s[7 * 33]);
        *(GAS v4u*)(WT + (size_t)(n0 + n) * K + k0 + 8 * c) = o; }
    LDS_WAIT(); asm volatile("" ::: "memory");
}

__device__ __forceinline__ void win_amax_partials(Frame& F, GAS const float* W, const int N, GAS float* WAM, const int gw, const int ngw) {
    const int ncg = N / 256;
    for (int item = gw; item < ncg * 16; item += ngw) {
        const int cg = item % ncg, ks = item / ncg, col = cg * 256 + F.lane * 4;
        f32x4 am = {0.f, 0.f, 0.f, 0.f};
        for (int k0 = 0; k0 < 128; k0 += 8) {
            f32x4 w[8];
#pragma unroll
            for (int kk = 0; kk < 8; ++kk) w[kk] = *(GAS const f32x4*)(W + (size_t)(ks * 128 + k0 + kk) * N + col);
#pragma unroll
            for (int kk = 0; kk < 8; ++kk) { am.x = fmaxf(am.x, fabsf(w[kk].x)); am.y = fmaxf(am.y, fabsf(w[kk].y)); am.z = fmaxf(am.z, fabsf(w[kk].z)); am.w = fmaxf(am.w, fabsf(w[kk].w)); }
        }
        *(GAS f32x4*)(WAM + (size_t)ks * N + col) = am;
    }
}
__device__ __forceinline__ void win_transpose_q8(Frame& F, GAS const float* W, const int N, GAS const float* WAM, GAS unsigned char* WT, GAS float* WSC, const int gw, const int ngw) {
    LAS float* scr = (LAS float*)(F.lds + F.wave * 16384);
    const int lane = F.lane;
    for (int item = gw; item < (D / 64) * (N / 32); item += ngw) {
        const int nblk = N / 32, kb = item / nblk, nb = item % nblk, k0 = 64 * kb, n0 = 32 * nb;
        f32x4 tv[8];
#pragma unroll
        for (int i = 0; i < 8; ++i) { const int kk = 8 * i + (lane >> 3); tv[i] = *(GAS const f32x4*)(W + (size_t)(k0 + kk) * N + n0 + 4 * (lane & 7)); }
        const int n = lane >> 1, half = lane & 1;
        float am = 0.f;
#pragma unroll
        for (int ks = 0; ks < 16; ++ks) am = fmaxf(am, WAM[(size_t)ks * N + n0 + n]);
#pragma unroll
        for (int i = 0; i < 8; ++i) { const int kk = 8 * i + (lane >> 3); LAS float* sp = scr + kk * 33 + 4 * (lane & 7); sp[0] = tv[i].x; sp[1] = tv[i].y; sp[2] = tv[i].z; sp[3] = tv[i].w; }
        LDS_WAIT(); asm volatile("" ::: "memory");
        const float inv = am > 0.f ? 127.0f / am : 0.f;
        if (kb == 0 && half == 0) WSC[n0 + n] = am > 0.f ? am * (1.0f / 127.0f) : 0.f;
        unsigned wq[8];
#pragma unroll
        for (int d = 0; d < 8; ++d) { const LAS float* sp = scr + (32 * half + 4 * d) * 33 + n;
            const int q0 = __float2int_rn(sp[0] * inv), q1 = __float2int_rn(sp[33] * inv), q2 = __float2int_rn(sp[66] * inv), q3 = __float2int_rn(sp[99] * inv);
            wq[d] = (unsigned)((q0 & 0xff) | ((q1 & 0xff) << 8) | ((q2 & 0xff) << 16) | ((q3 & 0xff) << 24)); }
        GAS unsigned char* dp = WT + (size_t)(n0 + n) * D + k0 + 32 * half;
        *(GAS v4u*)dp = (v4u){wq[0], wq[1], wq[2], wq[3]}; *(GAS v4u*)(dp + 16) = (v4u){wq[4], wq[5], wq[6], wq[7]};
        LDS_WAIT(); asm volatile("" ::: "memory");
    }
}
__device__ __forceinline__ void weight_transposes(Frame& F, const int gw, const int ngw) {
    LAS float* scr = (LAS float*)(F.lds + F.wave * 16384);
    constexpr int I_IN = (D / 64) * (INW / 32), I_GLU = (1024 / 64) * (1024 / 32), I_POOL1 = (256 / 64) * (256 / 32), I_PA = (1024 / 64) * (D / 32), I_WO = (D / 64) * (D / 32);
    constexpr int NITEMS = I_GLU + 4 * I_POOL1 + 2 * I_PA + 2 * I_WO;
    for (int it = gw; it < NITEMS; it += ngw) {
        int r = it;
        if (r < I_GLU) { transpose_item(F.inp(17), 1024, 1024, (GAS bf16*)(F.ws + WS_WGLU), scr, r, F.lane); continue; } r -= I_GLU;
        if (r < 4 * I_POOL1) { const int grp = r / I_POOL1; transpose_item(F.inp(19) + (size_t)grp * 65536, 256, 256, (GAS bf16*)(F.ws + WS_WPOOL) + (size_t)grp * 65536, scr, r % I_POOL1, F.lane); continue; } r -= 4 * I_POOL1;
        if (r < I_PA) { transpose_item(F.inp(21), 1024, D, (GAS bf16*)(F.ws + WS_PROJA), scr, r, F.lane); continue; } r -= I_PA;
        if (r < I_PA) { transpose_item(F.inp(22), 1024, D, (GAS bf16*)(F.ws + WS_PROJB), scr, r, F.lane); continue; } r -= I_PA;
        if (r < I_WO) { transpose_item(F.inp(23), D, D, (GAS bf16*)(F.ws + WS_WOUT), scr, r, F.lane); continue; } r -= I_WO;
        if (!Q_I8) transpose_item(F.inp(24), D, D, (GAS bf16*)(F.ws + WS_WQ), scr, r, F.lane);
    }
}
__device__ __forceinline__ void p1_convert(Frame& F) {
    for (int e = F.gw * 64 + F.lane; e < 5 * NMOD; e += F.NGW * 64) { const int col = e % NMOD; GAS const float* MODP = (GAS const float*)(F.ws + WS_MODP); float s = F.inp(5)[col];
        for (int ks = 0; ks < KS_MOD; ++ks) s += MODP[(size_t)ks * 5 * NMOD + e];
        ((GAS float*)(F.ws + WS_MOD))[e] = s; }
    for (int e = F.gw * 64 + F.lane; e < 2 * 16384; e += F.NGW * 64) { const float v = e < 16384 ? F.inp(25)[e] : F.inp(26)[e - 16384]; ((GAS bf16*)(F.ws + WS_K12))[e] = (bf16)f2bf(v); }
}
__device__ __forceinline__ void win_quant_strip(Frame& F, GAS const float* W, const int N, GAS unsigned char* WT, GAS float* WSC, const int strip) {
    LAS unsigned* T32 = (LAS unsigned*)F.lds;
    LAS float* AM = (LAS float*)(F.lds + 32 * 513 * 4);
    LAS float* AM2 = AM + 64 * 32;
    const int w = F.wave, g = F.lane >> 3, cq = F.lane & 7, n0 = strip * 32;
    f32x4 v[8][4];
#pragma unroll
    for (int sp = 0; sp < 8; ++sp)
#pragma unroll
        for (int i = 0; i < 4; ++i) v[sp][i] = *(GAS const f32x4*)(W + (size_t)(sp * 256 + w * 32 + 4 * g + i) * N + n0 + 4 * cq);
    f32x4 am = {0.f, 0.f, 0.f, 0.f};
#pragma unroll
    for (int sp = 0; sp < 8; ++sp)
#pragma unroll
        for (int i = 0; i < 4; ++i) { am.x = fmaxf(am.x, fabsf(v[sp][i].x)); am.y = fmaxf(am.y, fabsf(v[sp][i].y)); am.z = fmaxf(am.z, fabsf(v[sp][i].z)); am.w = fmaxf(am.w, fabsf(v[sp][i].w)); }
    *(LAS f32x4*)(AM + (w * 8 + g) * 32 + 4 * cq) = am;
    __syncthreads();
    if (F.tid < 256) { const int col = F.tid & 31, p8 = F.tid >> 5; float m = 0.f;
#pragma unroll
        for (int j = 0; j < 8; ++j) m = fmaxf(m, AM[(p8 * 8 + j) * 32 + col]);
        AM2[p8 * 32 + col] = m; }
    __syncthreads();
    f32x4 cm = {0.f, 0.f, 0.f, 0.f};
#pragma unroll
    for (int j = 0; j < 8; ++j) { const f32x4 t = *(const LAS f32x4*)(AM2 + j * 32 + 4 * cq); cm.x = fmaxf(cm.x, t.x); cm.y = fmaxf(cm.y, t.y); cm.z = fmaxf(cm.z, t.z); cm.w = fmaxf(cm.w, t.w); }
    float inv[4];
#pragma unroll
    for (int e = 0; e < 4; ++e) inv[e] = cm[e] > 0.f ? 127.0f / cm[e] : 0.f;
    if (F.tid < 8) {
#pragma unroll
        for (int e = 0; e < 4; ++e) WSC[n0 + 4 * cq + e] = cm[e] > 0.f ? cm[e] * (1.0f / 127.0f) : 0.f; }
#pragma unroll
    for (int sp = 0; sp < 8; ++sp)
#pragma unroll
        for (int e = 0; e < 4; ++e) {
            const int q0 = __float2int_rn(v[sp][0][e] * inv[e]), q1 = __float2int_rn(v[sp][1][e] * inv[e]), q2 = __float2int_rn(v[sp][2][e] * inv[e]), q3 = __float2int_rn(v[sp][3][e] * inv[e]);
            T32[(4 * cq + e) * 513 + sp * 64 + w * 8 + g] = (unsigned)((q0 & 0xff) | ((q1 & 0xff) << 8) | ((q2 & 0xff) << 16) | ((q3 & 0xff) << 24)); }
    __syncthreads();
#pragma unroll
    for (int j = 0; j < 8; ++j) { const int ch = F.tid + 512 * j, n = ch >> 7, kc = ch & 127; const LAS unsigned* tp = T32 + n * 513 + kc * 4;
        *(GAS v4u*)(WT + (size_t)(n0 + n) * D + kc * 16) = (v4u){tp[0], tp[1], tp[2], tp[3]}; }
    __syncthreads();
}
template <bool Q8, int NR, bool BF = true, int DELTA = 0>
__device__ __forceinline__ void modnorm_rows(int lane, GAS const float* const (&xrow)[NR], GAS const bf16* const (&drow)[NR], GAS const float* nw, GAS const float* const (&shift)[NR], GAS const float* const (&scale)[NR], GAS bf16* const (&orow)[NR], GAS unsigned char* const (&qrow)[NR], GAS float* const (&qscl)[NR]) {
    f32x4 v[NR][8]; float rstd[NR];
#pragma unroll
    for (int r = 0; r < NR; ++r)
#pragma unroll
        for (int j = 0; j < 8; ++j) {
            if (DELTA == 2) { const v2u dw = *(GAS const v2u*)(drow[r] + j * 256 + lane * 4); v[r][j] = (f32x4){bflo(dw.x), bfhi(dw.x), bflo(dw.y), bfhi(dw.y)}; continue; }
            v[r][j] = *(GAS const f32x4*)(xrow[r] + j * 256 + lane * 4);
            if (DELTA == 1) { const v2u dw = *(GAS const v2u*)(drow[r] + j * 256 + lane * 4); v[r][j] += (f32x4){bflo(dw.x), bfhi(dw.x), bflo(dw.y), bfhi(dw.y)}; } }
#pragma unroll
    for (int r = 0; r < NR; ++r) { float s = 0.f;
#pragma unroll
        for (int j = 0; j < 8; ++j) s += (v[r][j].x * v[r][j].x + v[r][j].y * v[r][j].y) + (v[r][j].z * v[r][j].z + v[r][j].w * v[r][j].w);
        rstd[r] = 1.0f / sqrtf(wave_sum(s) * (1.0f / D) + EPS); }
#pragma unroll
    for (int r = 0; r < NR; ++r) {
        float am = 0.f;
#pragma unroll
        for (int j = 0; j < 8; ++j) { const int col = j * 256 + lane * 4;
            const f32x4 w = *(GAS const f32x4*)(nw + col), sc = *(GAS const f32x4*)(scale[r] + col), sh = *(GAS const f32x4*)(shift[r] + col);
            const f32x4 o = (v[r][j] * rstd[r]) * w * (sc + 1.0f) + sh;
            if (BF) { v2u pw; pw.x = pk2(o.x, o.y); pw.y = pk2(o.z, o.w); *(GAS v2u*)(orow[r] + col) = pw; }
            if (Q8) { v[r][j] = o; am = fmaxf(am, fmaxf(fmaxf(fabsf(o.x), fabsf(o.y)), fmaxf(fabsf(o.z), fabsf(o.w)))); } }
        if (Q8) {
            am = wave_max(am);
            const float inv = am > 0.f ? 127.0f / am : 0.f;
            if (lane == 0) *qscl[r] = am > 0.f ? am * (1.0f / 127.0f) : 0.f;
#pragma unroll
            for (int j = 0; j < 8; ++j) { const int q0 = __float2int_rn(v[r][j].x * inv), q1 = __float2int_rn(v[r][j].y * inv), q2 = __float2int_rn(v[r][j].z * inv), q3 = __float2int_rn(v[r][j].w * inv);
                *(GAS int*)(qrow[r] + j * 256 + lane * 4) = (q0 & 0xff) | ((q1 & 0xff) << 8) | ((q2 & 0xff) << 16) | ((q3 & 0xff) << 24); }
        }
    }
}
template <bool BF, bool SRC16>
__device__ __forceinline__ void modnorm_group(int lane, const int ng, GAS const void* src0, GAS const float* nw, GAS const float* shift, GAS const float* scale, GAS bf16* o0, GAS unsigned char* q0, GAS float* qs0) {
    f32x4 A[8], B[8];
#pragma unroll
    for (int j = 0; j < 8; ++j) { const int col = j * 256 + lane * 4; const f32x4 w = *(GAS const f32x4*)(nw + col), sc = *(GAS const f32x4*)(scale + col); A[j] = w * (sc + 1.0f); B[j] = *(GAS const f32x4*)(shift + col); }
    f32x4 nf[2][8]; v2u nh[2][8];
#define MG_LOAD(rp) do { _Pragma("unroll") for (int q = 0; q < 2; ++q) _Pragma("unroll") for (int j = 0; j < 8; ++j) { const size_t eo = (size_t)((rp) + q) * D + j * 256 + lane * 4; \
        if (SRC16) nh[q][j] = *(GAS const v2u*)((GAS const bf16*)src0 + eo); else nf[q][j] = *(GAS const f32x4*)((GAS const float*)src0 + eo); } } while (0)
    MG_LOAD(0);
#pragma unroll 1
    for (int rp = 0; rp < ng; rp += 2) {
        f32x4 v[2][8]; float rstd[2];
#pragma unroll
        for (int q = 0; q < 2; ++q)
#pragma unroll
            for (int j = 0; j < 8; ++j) v[q][j] = SRC16 ? (f32x4){bflo(nh[q][j].x), bfhi(nh[q][j].x), bflo(nh[q][j].y), bfhi(nh[q][j].y)} : nf[q][j];
        { const int rn = rp + 2 < ng ? rp + 2 : rp; MG_LOAD(rn); }
#pragma unroll
        for (int q = 0; q < 2; ++q) { float ss = 0.f;
#pragma unroll
            for (int j = 0; j < 8; ++j) ss += (v[q][j].x * v[q][j].x + v[q][j].y * v[q][j].y) + (v[q][j].z * v[q][j].z + v[q][j].w * v[q][j].w);
            rstd[q] = 1.0f / sqrtf(wave_sum(ss) * (1.0f / D) + EPS); }
#pragma unroll
        for (int q = 0; q < 2; ++q) { float am = 0.f; const size_t ro = (size_t)(rp + q) * D;
#pragma unroll
            for (int j = 0; j < 8; ++j) { const f32x4 o = (v[q][j] * rstd[q]) * A[j] + B[j]; v[q][j] = o;
                if (BF) { v2u pw; pw.x = pk2(o.x, o.y); pw.y = pk2(o.z, o.w); *(GAS v2u*)(o0 + ro + j * 256 + lane * 4) = pw; }
                am = fmaxf(am, fmaxf(fmaxf(fabsf(o.x), fabsf(o.y)), fmaxf(fabsf(o.z), fabsf(o.w)))); }
            am = wave_max(am);
            const float inv = am > 0.f ? 127.0f / am : 0.f;
            if (lane == 0) qs0[rp + q] = am > 0.f ? am * (1.0f / 127.0f) : 0.f;
#pragma unroll
            for (int j = 0; j < 8; ++j) { const int q0i = __float2int_rn(v[q][j].x * inv), q1 = __float2int_rn(v[q][j].y * inv), q2 = __float2int_rn(v[q][j].z * inv), q3 = __float2int_rn(v[q][j].w * inv);
                *(GAS int*)(q0 + ro + j * 256 + lane * 4) = (q0i & 0xff) | ((q1 & 0xff) << 8) | ((q2 & 0xff) << 16) | ((q3 & 0xff) << 24); }
        }
    }
#undef MG_LOAD
}
__device__ __forceinline__ void s5_scan(Frame& F, int blk) {
    const int gt = blk * 512 + F.tid;
    const int p = gt & 63, dir = (gt >> 6) & 1, g = (gt >> 7) & 63, b = gt >> 13;
    const float dt = expf(F.inp(11)[dir * 64 + g]);
    const float ar = F.inp(9)[(dir * 64 + g) * 64 + p], ai = F.inp(10)[(dir * 64 + g) * 64 + p];
    const float mag = expf((float)TCH * dt * ar); float sn, cs; sincosf((float)TCH * dt * ai, &sn, &cs);
    const float atr = mag * cs, ati = mag * sn;
    GAS const bf16* HL = (GAS const bf16*)(F.ws + WS_F) + (size_t)g * CROWS * 256 + dir * 128 + p;
    GAS bf16* UH = (GAS bf16*)(F.ws + WS_B) + (size_t)g * CROWS * USLD + 512 + dir * 128 + p;
    float hr = 0.f, hi = 0.f;
    {
        float lr[8], li[8];
#pragma unroll
        for (int q = 0; q < 8; ++q) { const int row = 512 + b * NCHC + (dir ? NCHC - 1 - q : q); lr[q] = __builtin_bit_cast(float, (unsigned)HL[(size_t)row * 256] << 16); li[q] = __builtin_bit_cast(float, (unsigned)HL[(size_t)row * 256 + 64] << 16); }
#pragma unroll
        for (int q = 0; q < 8; ++q) { const float nr = atr * hr - ati * hi + lr[q], ni = atr * hi + ati * hr + li[q]; hr = nr; hi = ni; }
        if (DIAG == 11) { hr = 0.f; hi = 0.f; }
    }
#pragma unroll 1
    for (int i0 = 0; i0 < NCHL; i0 += 32) {
        float lr[32], li[32];
#pragma unroll
        for (int q = 0; q < 32; ++q) { const int row = b * NCHL + (dir ? NCHL - 1 - (i0 + q) : (i0 + q)); lr[q] = __builtin_bit_cast(float, (unsigned)HL[(size_t)row * 256] << 16); li[q] = __builtin_bit_cast(float, (unsigned)HL[(size_t)row * 256 + 64] << 16); }
#pragma unroll
        for (int q = 0; q < 32; ++q) { const int row = b * NCHL + (dir ? NCHL - 1 - (i0 + q) : (i0 + q));
            UH[(size_t)row * USLD] = (bf16)f2bf(hr); UH[(size_t)row * USLD + 64] = (bf16)f2bf(hi);
            const float nr = atr * hr - ati * hi + lr[q], ni = atr * hi + ati * hr + li[q]; hr = nr; hi = ni; }
    }
}

__device__ __forceinline__ void s5_scan4(Frame& F, int blk) {
    const int p = F.tid & 63, dir = (F.tid >> 6) & 1, seg = F.tid >> 7, g = blk & 63, b = blk >> 6;
    const float dt = expf(F.inp(11)[dir * 64 + g]);
    const float ar = F.inp(9)[(dir * 64 + g) * 64 + p], ai = F.inp(10)[(dir * 64 + g) * 64 + p];
    const float mag = expf((float)TCH * dt * ar); float sn, cs; sincosf((float)TCH * dt * ai, &sn, &cs);
    const float atr = mag * cs, ati = mag * sn;
    GAS const bf16* HL = (GAS const bf16*)(F.ws + WS_F) + (size_t)g * CROWS * 256 + dir * 128 + p;
    GAS bf16* UH = (GAS bf16*)(F.ws + WS_B) + (size_t)g * CROWS * USLD + 512 + dir * 128 + p;
    float cr[8], ci[8], lr[32], li[32];
#pragma unroll
    for (int q = 0; q < 8; ++q) { const int row = 512 + b * NCHC + (dir ? NCHC - 1 - q : q); cr[q] = __builtin_bit_cast(float, (unsigned)HL[(size_t)row * 256] << 16); ci[q] = __builtin_bit_cast(float, (unsigned)HL[(size_t)row * 256 + 64] << 16); }
#pragma unroll
    for (int q = 0; q < 32; ++q) { const int i = seg * 32 + q, row = b * NCHL + (dir ? NCHL - 1 - i : i); lr[q] = __builtin_bit_cast(float, (unsigned)HL[(size_t)row * 256] << 16); li[q] = __builtin_bit_cast(float, (unsigned)HL[(size_t)row * 256 + 64] << 16); }
    float hr = 0.f, hi = 0.f;
#pragma unroll
    for (int q = 0; q < 8; ++q) { const float nr = atr * hr - ati * hi + cr[q], ni = atr * hi + ati * hr + ci[q]; hr = nr; hi = ni; }
    if (DIAG == 11) { hr = 0.f; hi = 0.f; }
    float tr = 0.f, ti = 0.f;
#pragma unroll
    for (int q = 0; q < 32; ++q) { const float nr = atr * tr - ati * ti + lr[q], ni = atr * ti + ati * tr + li[q]; tr = nr; ti = ni; }
    float dr = atr, di = ati;
#pragma unroll
    for (int k = 0; k < 5; ++k) { const float nr = dr * dr - di * di, ni = 2.0f * dr * di; dr = nr; di = ni; }
    LAS float* TT = (LAS float*)F.lds;
    TT[F.tid * 2] = tr; TT[F.tid * 2 + 1] = ti;
    __syncthreads();
#pragma unroll
    for (int s2 = 0; s2 < 3; ++s2) if (s2 < seg) { const float xr = TT[(s2 * 128 + (F.tid & 127)) * 2], xi = TT[(s2 * 128 + (F.tid & 127)) * 2 + 1];
        const float nr = dr * hr - di * hi + xr, ni = dr * hi + di * hr + xi; hr = nr; hi = ni; }
#pragma unroll
    for (int q = 0; q < 32; ++q) { const int i = seg * 32 + q, row = b * NCHL + (dir ? NCHL - 1 - i : i);
        UH[(size_t)row * USLD] = (bf16)f2bf(hr); UH[(size_t)row * USLD + 64] = (bf16)f2bf(hi);
        const float nr = atr * hr - ati * hi + lr[q], ni = atr * hi + ati * hr + li[q]; hr = nr; hi = ni; }
    __syncthreads();
}
constexpr size_t WS_YN = WS_END;
__device__ __forceinline__ void s5_naive(Frame& F) {
    GAS const bf16* US = (GAS const bf16*)(F.ws + WS_B); GAS float* YN = (DIAG == 10 || DIAG == 11) ? F.out : (GAS float*)(F.ws + WS_YN);
    const int p = F.lane;
    for (int item = F.gw; item < NB * S5G; item += F.NGW) {
        const int b = item >> 6, g = item & 63;
        for (int dir = 0; dir < 2; ++dir) {
            const float dt = expf(F.inp(11)[dir * 64 + g]);
            const float ar = F.inp(9)[(dir * 64 + g) * 64 + p], ai = F.inp(10)[(dir * 64 + g) * 64 + p];
            const float mag = expf(dt * ar); float sn, cs; sincosf(dt * ai, &sn, &cs);
            const float abr = mag * cs, abi = mag * sn;
            const float nr = abr - 1.0f, ni = abi, den = ar * ar + ai * ai;
            const float fre = (nr * ar + ni * ai) / den, fim = (ni * ar - nr * ai) / den;
            float bbr[16], bbi[16], ccr[16], cci[16];
#pragma unroll
            for (int h = 0; h < 16; ++h) {
                const float br = F.inp(12)[((size_t)(dir * 64 + g) * 64 + p) * 16 + h], bi = F.inp(13)[((size_t)(dir * 64 + g) * 64 + p) * 16 + h];
                bbr[h] = fre * br - fim * bi; bbi[h] = fre * bi + fim * br;
                ccr[h] = F.inp(14)[((size_t)(dir * 64 + g) * 16 + h) * 64 + p]; cci[h] = F.inp(15)[((size_t)(dir * 64 + g) * 16 + h) * 64 + p];
            }
            float hr = 0.f, hi = 0.f;
            for (int step = 0; step < CTXL + SEQ; ++step) {
                const bool isctx = step < CTXL;
                const int tt = isctx ? (dir ? CTXL - 1 - step : step) : (dir ? SEQ - 1 - (step - CTXL) : (step - CTXL));
                const int crow = isctx ? 512 + b * NCHC + (tt >> 5) : b * NCHL + (tt >> 5);
                GAS const bf16* up = US + ((size_t)g * CROWS + crow) * USLD + (tt & 31) * 16;
                const v4u u0 = *(GAS const v4u*)up, u1 = *(GAS const v4u*)(up + 8);
                float uu[16];
                uu[0] = bflo(u0.x); uu[1] = bfhi(u0.x); uu[2] = bflo(u0.y); uu[3] = bfhi(u0.y); uu[4] = bflo(u0.z); uu[5] = bfhi(u0.z); uu[6] = bflo(u0.w); uu[7] = bfhi(u0.w);
                uu[8] = bflo(u1.x); uu[9] = bfhi(u1.x); uu[10] = bflo(u1.y); uu[11] = bfhi(u1.y); uu[12] = bflo(u1.z); uu[13] = bfhi(u1.z); uu[14] = bflo(u1.w); uu[15] = bfhi(u1.w);
                float br = 0.f, bi = 0.f;
#pragma unroll
                for (int h = 0; h < 16; ++h) { br += bbr[h] * uu[h]; bi += bbi[h] * uu[h]; }
                const float nhr = abr * hr - abi * hi + br, nhi = abr * hi + abi * hr + bi; hr = nhr; hi = nhi;
                if (!isctx) {
                    float yv = 0.f;
#pragma unroll
                    for (int h = 0; h < 16; ++h) { const float part = wave_sum(ccr[h] * hr - cci[h] * hi); yv = (p == h) ? part : yv; }
                    if (p < 16) { GAS float* yp = YN + ((size_t)b * SEQ + tt) * S5W + g * 16 + p; *yp = (dir == 0) ? yv : (*yp + yv); }
                }
            }
        }
    }
}
template <int W> __device__ __forceinline__ void pool_seg(GAS const bf16* zp, GAS bf16* pp) {
    float v[64];
#pragma unroll
    for (int i = 0; i < 64; ++i) v[i] = __builtin_bit_cast(float, (unsigned)zp[(size_t)i * 1024] << 16);
#pragma unroll
    for (int pos = 0; pos < 64; ++pos) {
        const int lo = pos - W / 2 < 0 ? 0 : pos - W / 2, hi = pos + W / 2 - 1 > 63 ? 63 : pos + W / 2 - 1;
        float s = 0.f;
#pragma unroll
        for (int j = lo; j <= hi; ++j) s += v[j];
        pp[(size_t)pos * 1024] = (bf16)f2bf(s * (1.0f / (float)(hi - lo + 1)) - v[pos]);
    }
}
__device__ __forceinline__ void pool_prep(Frame& F, int blk, int nblk) {
    GAS const bf16* ZP = (GAS const bf16*)(F.ws + WS_G); GAS bf16* PP = (GAS bf16*)(F.ws + WS_C);
    for (int it = blk * NWAVES + F.wave; it < 256 * 16; it += nblk * NWAVES) {
        const int seg = it >> 4, cb = it & 15, ch = cb * 64 + F.lane, grp = cb >> 2;
        GAS const bf16* zp = ZP + (size_t)seg * 64 * 1024 + ch; GAS bf16* pp = PP + (size_t)seg * 64 * 1024 + ch;
        if (grp == 0) pool_seg<2>(zp, pp); else if (grp == 1) pool_seg<4>(zp, pp); else if (grp == 2) pool_seg<8>(zp, pp); else pool_seg<16>(zp, pp);
    }
}
template <int W> __device__ __forceinline__ void pool_seg4(GAS const bf16* zp, GAS bf16* pp) {
    v2u r[64];
#pragma unroll
    for (int i = 0; i < 64; ++i) r[i] = *(GAS const v2u*)(zp + (size_t)i * 1024);
#define PU4(w) ((f32x4){bflo((w).x), bfhi((w).x), bflo((w).y), bfhi((w).y)})
    f32x4 s = {0.f, 0.f, 0.f, 0.f};
#pragma unroll
    for (int j = 0; j < W / 2; ++j) s += PU4(r[j]);
#pragma unroll
    for (int pos = 0; pos < 64; ++pos) {
        const int lo = pos - W / 2 < 0 ? 0 : pos - W / 2, hi = pos + W / 2 - 1 > 63 ? 63 : pos + W / 2 - 1;
        const f32x4 o = s * (1.0f / (float)(hi - lo + 1)) - PU4(r[pos]);
        v2u w; w.x = pk2(o.x, o.y); w.y = pk2(o.z, o.w);
        *(GAS v2u*)(pp + (size_t)pos * 1024) = w;
        if (pos + W / 2 <= 63) s += PU4(r[pos + W / 2]);
        if (pos - W / 2 >= 0) s -= PU4(r[pos - W / 2]);
    }
#undef PU4
}
__device__ __forceinline__ void pool_prep4(Frame& F, int blk, int nblk, const int nwv = 4, const int it0 = 0, const int it1 = 256 * 4) {
    GAS const bf16* ZP = (GAS const bf16*)(F.ws + WS_G); GAS bf16* PP = (GAS bf16*)(F.ws + WS_C);
    if (F.wave < nwv)
    for (int it = it0 + blk * nwv + F.wave; it < it1; it += nblk * nwv) {
        const int seg = it >> 2, grp = it & 3, ch = grp * 256 + F.lane * 4;
        GAS const bf16* zp = ZP + (size_t)seg * 64 * 1024 + ch; GAS bf16* pp = PP + (size_t)seg * 64 * 1024 + ch;
        if (grp == 0) pool_seg4<2>(zp, pp); else if (grp == 1) pool_seg4<4>(zp, pp); else if (grp == 2) pool_seg4<8>(zp, pp); else pool_seg4<16>(zp, pp);
    }
}
__device__ __forceinline__ void convert_table(Frame& F, GAS const float* src, GAS bf16* dst, size_t n) {
    for (size_t i = ((size_t)F.gw * 64 + F.lane) * 8; i < n; i += (size_t)F.NGW * 64 * 8) {
        const f32x4 a = *(GAS const f32x4*)(src + i), b = *(GAS const f32x4*)(src + i + 4);
        v4u w; w.x = pk2(a.x, a.y); w.y = pk2(a.z, a.w); w.z = pk2(b.x, b.y); w.w = pk2(b.z, b.w);
        *(GAS v4u*)(dst + i) = w;
    }
}

template <int N> __device__ __forceinline__ void bitonic_merge_desc(float (&a)[N]) {
#pragma unroll
    for (int j = N >> 1; j > 0; j >>= 1)
#pragma unroll
        for (int i = 0; i < N; ++i) { const int l = i ^ j; if (l > i) { const float hi = fmaxf(a[i], a[l]), lo = fminf(a[i], a[l]); a[i] = hi; a[l] = lo; } }
}
template <int N> __device__ __forceinline__ void bitonic_sort_desc(float (&a)[N]) {
#pragma unroll
    for (int k = 2; k <= N; k <<= 1)
#pragma unroll
        for (int j = k >> 1; j > 0; j >>= 1)
#pragma unroll
            for (int i = 0; i < N; ++i) { const int l = i ^ j; if (l > i) { const bool desc = ((i & k) == 0) || (k == N); const float hi = fmaxf(a[i], a[l]), lo = fminf(a[i], a[l]); a[i] = desc ? hi : lo; a[l] = desc ? lo : hi; } }
}
__device__ __forceinline__ void sort16_desc(float (&a)[16]) {
#define CE16(i, j) do { const float hi_ = fmaxf(a[i], a[j]), lo_ = fminf(a[i], a[j]); a[i] = hi_; a[j] = lo_; } while (0)
    CE16(0,1); CE16(2,3); CE16(4,5); CE16(6,7); CE16(8,9); CE16(10,11); CE16(12,13); CE16(14,15); CE16(0,2); CE16(1,3); CE16(4,6); CE16(5,7); CE16(8,10); CE16(9,11); CE16(12,14); CE16(13,15); CE16(1,2); CE16(5,6); CE16(9,10); CE16(13,14); CE16(0,4); CE16(1,5); CE16(2,6); CE16(3,7); CE16(8,12); CE16(9,13); CE16(10,14); CE16(11,15); CE16(2,4); CE16(3,5); CE16(10,12); CE16(11,13); CE16(1,2); CE16(3,4); CE16(5,6); CE16(9,10); CE16(11,12); CE16(13,14); CE16(0,8); CE16(1,9); CE16(2,10); CE16(3,11); CE16(4,12); CE16(5,13); CE16(6,14); CE16(7,15); CE16(4,8); CE16(5,9); CE16(6,10); CE16(7,11); CE16(2,4); CE16(3,5); CE16(6,8); CE16(7,9); CE16(10,12); CE16(11,13); CE16(1,2); CE16(3,4); CE16(5,6); CE16(7,8); CE16(9,10); CE16(11,12); CE16(13,14);
#undef CE16
}
__device__ __forceinline__ void top16_merge(float (&x)[16], const float (&y)[16]) {
#pragma unroll
    for (int i = 0; i < 16; ++i) x[i] = fmaxf(x[i], y[15 - i]);
    bitonic_merge_desc<16>(x);
}
constexpr int KT_STRIDE = 272;
constexpr int KT_BYTES = 2 * 128 * KT_STRIDE;
constexpr int EX_STRIDE = 33;
__device__ __forceinline__ void peer_topk(Frame& F) {
    { GAS const bf16* K12 = (GAS const bf16*)(F.ws + WS_K12);
      for (int c = F.tid; c < 2 * 128 * 16; c += 512) { const int row = c >> 4, ch = c & 15; *(LAS v4u*)(F.lds + row * KT_STRIDE + ch * 16) = *(GAS const v4u*)(K12 + (size_t)row * 128 + ch * 8); } }
    __syncthreads();
    LAS float* EX = (LAS float*)(F.lds + KT_BYTES + F.wave * (64 * EX_STRIDE * 4));
    GAS const bf16* Q = (GAS const bf16*)(F.ws + WS_A);
    GAS int* EID = (GAS int*)(F.ws + WS_EID); GAS float* GW = (GAS float*)(F.ws + WS_GW);
    const int fr = F.lane & 15, fq = F.lane >> 4;
    const float NEG = -3.0e38f;
    for (int item = F.gw; item < (M / 16) * 2; item += F.NGW) {
        const int tg = item >> 1, hq = item & 1;
        for (int hl = 0; hl < 4; ++hl) {
            const int head = hq * 4 + hl;
#pragma unroll
            for (int j = 0; j < 2; ++j) {
                bf16x8 qf[4];
#pragma unroll
                for (int ks = 0; ks < 4; ++ks) qf[ks] = *(GAS const bf16x8*)(Q + (size_t)(tg * 16 + fr) * D + head * 256 + j * 128 + ks * 32 + fq * 8);
                f32x4 acc[8];
#pragma unroll
                for (int n = 0; n < 8; ++n) { acc[n] = (f32x4){0.f, 0.f, 0.f, 0.f};
#pragma unroll
                    for (int ks = 0; ks < 4; ++ks) { const bf16x8 kf = *(const LAS bf16x8*)(F.lds + (j * 128 + n * 16 + fr) * KT_STRIDE + (ks * 32 + fq * 8) * 2);
                        acc[n] = __builtin_amdgcn_mfma_f32_16x16x32_bf16(kf, qf[ks], acc[n], 0, 0, 0); } }
                float sc[32];
#pragma unroll
                for (int n = 0; n < 8; ++n)
#pragma unroll
                    for (int i = 0; i < 4; ++i) { const float sv = acc[n][i]; sc[n * 4 + i] = __builtin_bit_cast(float, (__builtin_bit_cast(unsigned, sv) & ~127u) | (unsigned)(n * 16 + fq * 4 + i)); }
                float ta[16], tb[16];
#pragma unroll
                for (int e = 0; e < 16; ++e) { ta[e] = sc[e]; tb[e] = sc[16 + e]; }
                sort16_desc(ta); sort16_desc(tb); top16_merge(ta, tb);
#pragma unroll
                for (int e = 0; e < 16; ++e) tb[e] = __builtin_bit_cast(float, __builtin_amdgcn_ds_swizzle(__builtin_bit_cast(int, ta[e]), 0x401F));
                top16_merge(ta, tb);
#pragma unroll
                for (int e = 0; e < 16; ++e) tb[e] = shfl_idx(ta[e], F.lane ^ 32);
                top16_merge(ta, tb);
                if (fq == 0) {
#pragma unroll
                    for (int k = 0; k < 16; ++k) EX[(hl * 16 + fr) * EX_STRIDE + j * 16 + k] = ta[k];
                }
            }
        }
        LDS_WAIT(); asm volatile("" ::: "memory");
        {
            const int hl = F.lane >> 4, tok = tg * 16 + (F.lane & 15), head = hq * 4 + hl;
            float v1[16], v2[16];
#pragma unroll
            for (int k = 0; k < 16; ++k) { v1[k] = EX[F.lane * EX_STRIDE + k]; v2[k] = EX[F.lane * EX_STRIDE + 16 + k]; }
#define CANDV(a, b) __builtin_bit_cast(float, (__builtin_bit_cast(unsigned, __builtin_bit_cast(float, __builtin_bit_cast(unsigned, v1[a]) & ~127u) + __builtin_bit_cast(float, __builtin_bit_cast(unsigned, v2[b]) & ~127u)) & ~255u) | (unsigned)((a) * 16 + (b)))
            float top[16], l1[16], l2[16], l3[16];
#pragma unroll
            for (int b = 0; b < 16; ++b) top[b] = CANDV(0, b);
#pragma unroll
            for (int b = 0; b < 8; ++b) l1[b] = CANDV(1, b);
#pragma unroll
            for (int b = 0; b < 5; ++b) l1[8 + b] = CANDV(2, b);
#pragma unroll
            for (int b = 0; b < 3; ++b) l1[13 + b] = CANDV(4, b);
#pragma unroll
            for (int b = 0; b < 4; ++b) l2[b] = CANDV(3, b);
            l2[4] = CANDV(5, 0); l2[5] = CANDV(5, 1); l2[6] = CANDV(6, 0); l2[7] = CANDV(6, 1); l2[8] = CANDV(7, 0); l2[9] = CANDV(7, 1);
            l2[10] = CANDV(8, 0); l2[11] = CANDV(9, 0); l2[12] = CANDV(10, 0); l2[13] = CANDV(11, 0); l2[14] = CANDV(12, 0); l2[15] = CANDV(13, 0);
            { const float c14 = CANDV(14, 0), c15 = CANDV(15, 0); l3[0] = fmaxf(c14, c15); l3[1] = fminf(c14, c15); }
#pragma unroll
            for (int b = 2; b < 16; ++b) l3[b] = NEG;
#undef CANDV
            sort16_desc(top); sort16_desc(l1); sort16_desc(l2);
            top16_merge(top, l1); top16_merge(l2, l3); top16_merge(top, l2);
            float es[16], sum = 0.f; const float m0 = __builtin_bit_cast(float, __builtin_bit_cast(unsigned, top[0]) & ~255u);
            int ids[16];
#pragma unroll
            for (int k = 0; k < 16; ++k) {
                const unsigned bits = __builtin_bit_cast(unsigned, top[k]); const int a = (bits >> 4) & 15, b = bits & 15;
                const unsigned w1 = __builtin_bit_cast(unsigned, EX[F.lane * EX_STRIDE + a]), w2 = __builtin_bit_cast(unsigned, EX[F.lane * EX_STRIDE + 16 + b]);
                ids[k] = (int)((w1 & 127u) * 128u + (w2 & 127u));
                es[k] = __expf(__builtin_bit_cast(float, bits & ~255u) - m0); sum += es[k];
            }
            const float inv = 1.0f / sum;
            GAS int* ep = EID + (size_t)tok * 128 + head * 16; GAS float* gp = GW + (size_t)tok * 128 + head * 16;
#pragma unroll
            for (int k4 = 0; k4 < 4; ++k4) {
                *(GAS i32x4*)(ep + k4 * 4) = (i32x4){ids[k4 * 4], ids[k4 * 4 + 1], ids[k4 * 4 + 2], ids[k4 * 4 + 3]};
                *(GAS f32x4*)(gp + k4 * 4) = (f32x4){es[k4 * 4] * inv, es[k4 * 4 + 1] * inv, es[k4 * 4 + 2] * inv, es[k4 * 4 + 3] * inv};
            }
        }
        LDS_WAIT(); asm volatile("" ::: "memory");
    }
    __syncthreads();
}
__device__ __forceinline__ float dot2u(unsigned a, unsigned b, float acc) {
    return __builtin_amdgcn_fdot2_f32_bf16(__builtin_bit_cast(bf16x2_t, a), __builtin_bit_cast(bf16x2_t, b), acc, false);
}
__device__ __forceinline__ float dot8(const v4u a, const v4u b, float acc) {
    const unsigned a0 = a.x, a1 = a.y, a2 = a.z, a3 = a.w, b0 = b.x, b1 = b.y, b2 = b.z, b3 = b.w;
    acc = dot2u(a0, b0, acc); acc = dot2u(a1, b1, acc); acc = dot2u(a2, b2, acc); acc = dot2u(a3, b3, acc);
    return acc;
}
__device__ __forceinline__ void peer_gather(Frame& F) {
    GAS const bf16* H2 = (GAS const bf16*)(F.ws + WS_C); GAS const bf16* UT = (GAS const bf16*)(F.ws + WS_D); GAS const bf16* VT = (GAS const bf16*)(F.ws + WS_B);
    GAS const int* EID = (GAS const int*)(F.ws + WS_EID); GAS const float* GW = (GAS const float*)(F.ws + WS_GW);
    GAS const float* MOD = (GAS const float*)(F.ws + WS_MOD); GAS const float* fw = F.inp(29);
    GAS float* X = F.out;
    const int lane = F.lane;
    for (int tok = F.gw; tok < M; tok += F.NGW) {
        const int b = tok >> 12;
        v4u hreg[4];
#pragma unroll
        for (int j = 0; j < 4; ++j) hreg[j] = *(GAS const v4u*)(H2 + (size_t)tok * D + j * 512 + lane * 8);
        const int e0 = EID[(size_t)tok * 128 + lane], e1 = EID[(size_t)tok * 128 + 64 + lane];
        const float g0 = GW[(size_t)tok * 128 + lane], g1 = GW[(size_t)tok * 128 + 64 + lane];
        float act0 = 0.f, act1 = 0.f;
#pragma unroll 1
        for (int eb = 0; eb < 128; eb += 4) {
            v4u ur[4][4];
#pragma unroll
            for (int q = 0; q < 4; ++q) { const int e = eb + q; const int id = shfl_idx_i(e < 64 ? e0 : e1, e & 63);
                GAS const bf16* up = UT + (size_t)id * D + lane * 8;
#pragma unroll
                for (int j = 0; j < 4; ++j) ur[q][j] = *(GAS const v4u*)(up + j * 512); }
#pragma unroll
            for (int q = 0; q < 4; ++q) { float pp = 0.f;
#pragma unroll
                for (int j = 0; j < 4; ++j) pp = dot8(ur[q][j], hreg[j], pp);
                pp = wave_sum(pp);
                const int e = eb + q; const float a = gelu_tanh(pp);
                if (e < 64) act0 = (lane == e) ? a : act0; else act1 = (lane == (e - 64)) ? a : act1; }
        }
        act0 *= g0; act1 *= g1;
        if (DIAG == 1) { act0 = 0.f; act1 = 0.f; }
        if (DIAG == 3) { act0 = g0; act1 = g1; }
        float o[32];
#pragma unroll
        for (int i = 0; i < 32; ++i) o[i] = 0.f;
#pragma unroll 1
        for (int eb = 0; eb < 128; eb += 4) {
            v4u vr[4][4]; float aa[4];
#pragma unroll
            for (int q = 0; q < 4; ++q) { const int e = eb + q; const int id = shfl_idx_i(e < 64 ? e0 : e1, e & 63); aa[q] = shfl_idx(e < 64 ? act0 : act1, e & 63);
                GAS const bf16* vp = VT + (size_t)id * D + lane * 8;
#pragma unroll
                for (int j = 0; j < 4; ++j) vr[q][j] = *(GAS const v4u*)(vp + j * 512); }
#pragma unroll
            for (int q = 0; q < 4; ++q)
#pragma unroll
                for (int j = 0; j < 4; ++j) { const v4u w = vr[q][j]; const float a = aa[q];
                    o[j * 8 + 0] += a * bflo(w.x); o[j * 8 + 1] += a * bfhi(w.x); o[j * 8 + 2] += a * bflo(w.y); o[j * 8 + 3] += a * bfhi(w.y);
                    o[j * 8 + 4] += a * bflo(w.z); o[j * 8 + 5] += a * bfhi(w.z); o[j * 8 + 6] += a * bflo(w.w); o[j * 8 + 7] += a * bfhi(w.w); }
        }
        GAS const float* g2 = MOD + (size_t)b * NMOD + 5 * D;
        float ss = 0.f;
#pragma unroll
        for (int j = 0; j < 4; ++j) { const int col = j * 512 + lane * 8;
            const f32x4 xa = *(GAS const f32x4*)(X + (size_t)tok * D + col), xb = *(GAS const f32x4*)(X + (size_t)tok * D + col + 4);
            const f32x4 ga = *(GAS const f32x4*)(g2 + col), gb = *(GAS const f32x4*)(g2 + col + 4);
            o[j * 8 + 0] = xa.x + ga.x * o[j * 8 + 0]; o[j * 8 + 1] = xa.y + ga.y * o[j * 8 + 1]; o[j * 8 + 2] = xa.z + ga.z * o[j * 8 + 2]; o[j * 8 + 3] = xa.w + ga.w * o[j * 8 + 3];
            o[j * 8 + 4] = xb.x + gb.x * o[j * 8 + 4]; o[j * 8 + 5] = xb.y + gb.y * o[j * 8 + 5]; o[j * 8 + 6] = xb.z + gb.z * o[j * 8 + 6]; o[j * 8 + 7] = xb.w + gb.w * o[j * 8 + 7];
#pragma unroll
            for (int i = 0; i < 8; ++i) ss += o[j * 8 + i] * o[j * 8 + i]; }
        const float rstd = 1.0f / sqrtf(wave_sum(ss) * (1.0f / D) + EPS);
#pragma unroll
        for (int j = 0; j < 4; ++j) { const int col = j * 512 + lane * 8;
            const f32x4 wa = *(GAS const f32x4*)(fw + col), wb = *(GAS const f32x4*)(fw + col + 4);
            *(GAS f32x4*)(X + (size_t)tok * D + col) = (f32x4){o[j * 8 + 0] * rstd * wa.x, o[j * 8 + 1] * rstd * wa.y, o[j * 8 + 2] * rstd * wa.z, o[j * 8 + 3] * rstd * wa.w};
            *(GAS f32x4*)(X + (size_t)tok * D + col + 4) = (f32x4){o[j * 8 + 4] * rstd * wb.x, o[j * 8 + 5] * rstd * wb.y, o[j * 8 + 6] * rstd * wb.z, o[j * 8 + 7] * rstd * wb.w}; }
    }
}


#define DPP_ADDF(v, ctrl) (v) += __builtin_bit_cast(float, __builtin_amdgcn_update_dpp(0, __builtin_bit_cast(int, (v)), (ctrl), 0xf, 0xf, false))
constexpr int PS_NS = 32, PS_SD = 64;
#define PS_LOAD_IDS(dst, b) do { _Pragma("unroll") for (int q = 0; q < 4; ++q) { const i32x4 t4 = *(const LAS i32x4*)(EIDT + g * 128 + (b) * 16 + q * 4); \
        dst[q * 4] = t4.x; dst[q * 4 + 1] = t4.y; dst[q * 4 + 2] = t4.z; dst[q * 4 + 3] = t4.w; } } while (0)
#define PS_ISSUE(rows, base, loff, ids) do { _Pragma("unroll") for (int i = 0; i < 16; ++i) rows[i] = *(GAS const v4u*)((base) + (((unsigned)ids[i] << 12) + (loff))); } while (0)
__device__ __forceinline__ void peer_sliced(Frame& F) {
    GAS const bf16* H2 = (GAS const bf16*)(F.ws + WS_C); GAS const char* UT = (GAS const char*)(F.ws + WS_D); GAS const char* VT = (GAS const char*)(F.ws + WS_B);
    GAS const int* EID = (GAS const int*)(F.ws + WS_EID); GAS const float* GW = (GAS const float*)(F.ws + WS_GW);
    GAS bf16* PO = (GAS bf16*)(F.ws + WS_A);
    GAS const float* MOD = (GAS const float*)(F.ws + WS_MOD); GAS const float* fw = F.inp(29);
    GAS float* X = F.out;
    const int lane = F.lane, g = lane >> 3, c = lane & 7;
    LAS int* EIDT = (LAS int*)(F.lds + F.wave * 8192);
    LAS float* ACTT = (LAS float*)(F.lds + F.wave * 8192 + 4096);
    for (int grp = blockIdx.x; grp < M / 64; grp += F.G) {
        const int tok0 = grp * 64 + F.wave * 8;
#pragma unroll
        for (int tt = 0; tt < 8; ++tt) { const unsigned eo = (unsigned)(tok0 + tt) * 128u + (unsigned)lane; EIDT[tt * 128 + lane] = EID[eo]; EIDT[tt * 128 + 64 + lane] = EID[eo + 64u]; }
        LDS_WAIT(); asm volatile("" ::: "memory");
        {
            float acc[16];
#pragma unroll
            for (int k = 0; k < 16; ++k) acc[k] = 0.f;
            v4u rA[16], rB[16]; int ids[16];
            const unsigned c16 = (unsigned)c * 16u;
            PS_LOAD_IDS(ids, 0); PS_ISSUE(rA, UT, c16, ids);
#pragma unroll 1
            for (int s = 0; s < PS_NS; ++s) {
                const v4u h2v = *(GAS const v4u*)((GAS const char*)H2 + ((unsigned)(tok0 + g) * (D * 2) + (unsigned)s * (PS_SD * 2) + c16));
                const unsigned ubs = c16 + (unsigned)s * (PS_SD * 2), ubn = c16 + (unsigned)(s + 1 < PS_NS ? s + 1 : s) * (PS_SD * 2);
#define PS_U_STEP(b, cur, nxt) do { \
                    PS_LOAD_IDS(ids, ((b) + 1) & 7); PS_ISSUE(nxt, UT, ((b) == 7 ? ubn : ubs), ids); \
                    asm volatile("" ::: "memory"); \
                    _Pragma("unroll") for (int i = 0; i < 16; ++i) { float p = dot8(cur[i], h2v, 0.f); \
                        DPP_ADDF(p, 0xB1); DPP_ADDF(p, 0x4E); DPP_ADDF(p, 0x141); \
                        acc[(b) * 2 + (i >> 3)] += (c == (i & 7)) ? p : 0.f; } \
                    asm volatile("" ::: "memory"); } while (0)
                PS_U_STEP(0, rA, rB); PS_U_STEP(1, rB, rA); PS_U_STEP(2, rA, rB); PS_U_STEP(3, rB, rA);
                PS_U_STEP(4, rA, rB); PS_U_STEP(5, rB, rA); PS_U_STEP(6, rA, rB); PS_U_STEP(7, rB, rA);
#undef PS_U_STEP
            }
            unsigned long long wsl = (unsigned long long)F.ws; asm volatile("" : "+s"(wsl));
            GAS const float* GWl = (GAS const float*)((GAS unsigned char*)wsl + WS_GW); const unsigned go = (unsigned)(tok0 + g) * 128u + (unsigned)c;
#pragma unroll
            for (int k = 0; k < 16; ++k) ACTT[g * 128 + 8 * k + c] = gelu_tanh(acc[k]) * GWl[go + 8u * k];
        }
        LDS_WAIT(); asm volatile("" ::: "memory");
        {
            v4u rA[16], rB[16]; int ids[16]; float av[16];
            const unsigned c16 = (unsigned)c * 16u;
            PS_LOAD_IDS(ids, 0); PS_ISSUE(rA, VT, c16, ids);
#pragma unroll 1
            for (int s = 0; s < PS_NS; ++s) {
                const unsigned vbs = c16 + (unsigned)s * (PS_SD * 2), vbn = c16 + (unsigned)(s + 1 < PS_NS ? s + 1 : s) * (PS_SD * 2);
                float o[8];
#pragma unroll
                for (int k = 0; k < 8; ++k) o[k] = 0.f;
#define PS_V_STEP(b, cur, nxt) do { \
                    PS_LOAD_IDS(ids, ((b) + 1) & 7); PS_ISSUE(nxt, VT, ((b) == 7 ? vbn : vbs), ids); \
                    _Pragma("unroll") for (int q = 0; q < 4; ++q) { const f32x4 a4 = *(const LAS f32x4*)(ACTT + g * 128 + (b) * 16 + q * 4); av[q * 4] = a4.x; av[q * 4 + 1] = a4.y; av[q * 4 + 2] = a4.z; av[q * 4 + 3] = a4.w; } \
                    asm volatile("" ::: "memory"); \
                    _Pragma("unroll") for (int i = 0; i < 16; ++i) { const v4u w = cur[i]; const float a = av[i]; \
                        o[0] += a * bflo(w.x); o[1] += a * bfhi(w.x); o[2] += a * bflo(w.y); o[3] += a * bfhi(w.y); o[4] += a * bflo(w.z); o[5] += a * bfhi(w.z); o[6] += a * bflo(w.w); o[7] += a * bfhi(w.w); } \
                    asm volatile("" ::: "memory"); } while (0)
                PS_V_STEP(0, rA, rB); PS_V_STEP(1, rB, rA); PS_V_STEP(2, rA, rB); PS_V_STEP(3, rB, rA);
                PS_V_STEP(4, rA, rB); PS_V_STEP(5, rB, rA); PS_V_STEP(6, rA, rB); PS_V_STEP(7, rB, rA);
#undef PS_V_STEP
                v4u w; w.x = pk2(o[0], o[1]); w.y = pk2(o[2], o[3]); w.z = pk2(o[4], o[5]); w.w = pk2(o[6], o[7]);
                *(GAS v4u*)((GAS char*)PO + ((unsigned)(tok0 + g) * (D * 2) + (unsigned)s * (PS_SD * 2) + c16)) = w;
            }
        }
        VM_WAIT();
#pragma unroll 1
        for (int tt = 0; tt < 8; ++tt) {
            const int tok = tok0 + tt; GAS const float* g2 = MOD + (size_t)(tok >> 12) * NMOD + 5 * D;
            float o[32]; float ss = 0.f;
#pragma unroll
            for (int j = 0; j < 4; ++j) { const int col = j * 512 + lane * 8;
                const f32x4 xa = *(GAS const f32x4*)(X + (size_t)tok * D + col), xb = *(GAS const f32x4*)(X + (size_t)tok * D + col + 4);
                const f32x4 ga = *(GAS const f32x4*)(g2 + col), gb = *(GAS const f32x4*)(g2 + col + 4);
                const v4u pw = *(GAS const v4u*)(PO + (size_t)tok * D + col);
                o[j * 8 + 0] = xa.x + ga.x * bflo(pw.x); o[j * 8 + 1] = xa.y + ga.y * bfhi(pw.x); o[j * 8 + 2] = xa.z + ga.z * bflo(pw.y); o[j * 8 + 3] = xa.w + ga.w * bfhi(pw.y);
                o[j * 8 + 4] = xb.x + gb.x * bflo(pw.z); o[j * 8 + 5] = xb.y + gb.y * bfhi(pw.z); o[j * 8 + 6] = xb.z + gb.z * bflo(pw.w); o[j * 8 + 7] = xb.w + gb.w * bfhi(pw.w);
#pragma unroll
                for (int i = 0; i < 8; ++i) ss += o[j * 8 + i] * o[j * 8 + i]; }
            const float rstd = 1.0f / sqrtf(wave_sum(ss) * (1.0f / D) + EPS);
#pragma unroll
            for (int j = 0; j < 4; ++j) { const int col = j * 512 + lane * 8;
                const f32x4 wa = *(GAS const f32x4*)(fw + col), wb = *(GAS const f32x4*)(fw + col + 4);
                *(GAS f32x4*)(X + (size_t)tok * D + col) = (f32x4){o[j * 8 + 0] * rstd * wa.x, o[j * 8 + 1] * rstd * wa.y, o[j * 8 + 2] * rstd * wa.z, o[j * 8 + 3] * rstd * wa.w};
                *(GAS f32x4*)(X + (size_t)tok * D + col + 4) = (f32x4){o[j * 8 + 4] * rstd * wb.x, o[j * 8 + 5] * rstd * wb.y, o[j * 8 + 6] * rstd * wb.z, o[j * 8 + 7] * rstd * wb.w}; }
        }
        LDS_WAIT(); asm volatile("" ::: "memory");
    }
}


#ifndef PEER_FP8
#define PEER_FP8 1
#endif
constexpr size_t WS_H8 = WS_G, WS_HSC = WS_I;
constexpr size_t WS_U8 = WS_T8, WS_V8 = WS_T8 + 32 * MiB, WS_USC = WS_K12 + 128 * 1024, WS_VSC = WS_K12 + 256 * 1024;
template <bool I8>
__device__ __forceinline__ void convert_rows4(Frame& F, GAS const float* src, GAS unsigned char* dst, GAS float* scl, const int r0) {
    constexpr int RB = 4; const float QM = I8 ? 127.0f : 448.0f;
    {
        f32x4 v[RB][8]; float am[RB];
#pragma unroll
        for (int q = 0; q < RB; ++q)
#pragma unroll
            for (int j = 0; j < 8; ++j) v[q][j] = *(GAS const f32x4*)(src + (size_t)(r0 + q) * D + j * 256 + F.lane * 4);
#pragma unroll
        for (int q = 0; q < RB; ++q) { float a = 0.f;
#pragma unroll
            for (int j = 0; j < 8; ++j) a = fmaxf(a, fmaxf(fmaxf(fabsf(v[q][j].x), fabsf(v[q][j].y)), fmaxf(fabsf(v[q][j].z), fabsf(v[q][j].w))));
            am[q] = wave_max(a); }
#pragma unroll
        for (int q = 0; q < RB; ++q) {
            const float inv = am[q] > 0.f ? QM / am[q] : 0.f;
            if (F.lane == 0) scl[r0 + q] = am[q] > 0.f ? am[q] * (1.0f / QM) : 0.f;
#pragma unroll
            for (int j = 0; j < 8; ++j) { int w;
                if (I8) { const int q0 = __float2int_rn(v[q][j].x * inv), q1 = __float2int_rn(v[q][j].y * inv), q2 = __float2int_rn(v[q][j].z * inv), q3 = __float2int_rn(v[q][j].w * inv);
                    w = (q0 & 0xff) | ((q1 & 0xff) << 8) | ((q2 & 0xff) << 16) | ((q3 & 0xff) << 24); }
                else { w = __builtin_amdgcn_cvt_pk_fp8_f32(v[q][j].x * inv, v[q][j].y * inv, 0, false); w = __builtin_amdgcn_cvt_pk_fp8_f32(v[q][j].z * inv, v[q][j].w * inv, w, true); }
                *(GAS int*)(dst + (size_t)(2 * j + (F.lane >> 5)) * ((size_t)PEER_E * 128) + (size_t)(r0 + q) * 128 + (F.lane & 31) * 4) = w; }
        }
    }
}
template <bool I8>
__device__ __forceinline__ void convert_table_q8(Frame& F, GAS const float* src, GAS unsigned char* dst, GAS float* scl, const int w0, const int nw) {
    for (int r0 = w0 * 4; r0 < PEER_E; r0 += nw * 4) convert_rows4<I8>(F, src, dst, scl, r0);
}
template <bool I8>
__device__ __forceinline__ void convert_table_q8_dyn(Frame& F, GAS const float* src, GAS unsigned char* dst, GAS float* scl, unsigned* ctr) {
    int item = 0;
    if (F.lane == 0) item = (int)__hip_atomic_fetch_add(ctr, 1u, __ATOMIC_RELAXED, __HIP_MEMORY_SCOPE_AGENT);
    item = __builtin_amdgcn_readfirstlane(item);
    while (item < PEER_E / 4) {
        int nxt = 0;
        if (F.lane == 0) nxt = (int)__hip_atomic_fetch_add(ctr, 1u, __ATOMIC_RELAXED, __HIP_MEMORY_SCOPE_AGENT);
        convert_rows4<I8>(F, src, dst, scl, item * 4);
        item = __builtin_amdgcn_readfirstlane(nxt);
    }
}
#ifndef BAR_PROBE
#define BAR_PROBE 0
#endif
#ifndef PEER_REP_ALL
#define PEER_REP_ALL 0
#endif
#ifndef PEER_REP_F
#define PEER_REP_F 0
#endif
#ifndef PEER_REP_U
#define PEER_REP_U 0
#endif
#ifndef PEER_REP_V
#define PEER_REP_V 0
#endif
#ifndef VALU_PROBE
#define VALU_PROBE 0
#endif
#ifndef SLICE_SYNC
#define SLICE_SYNC 0
#endif
constexpr int P8_NS = 16;
#define P8_ISSUE(rows, base, loff, ids) do { _Pragma("unroll") for (int i = 0; i < 16; ++i) rows[i] = *(GAS const v4u*)((base) + (((unsigned)ids[i] << 7) + (loff))); } while (0)
#define P8_LOAD_IDS(dst, b) do { _Pragma("unroll") for (int q = 0; q < 4; ++q) { const i32x4 t4 = *(const LAS i32x4*)(EIDT + g * 132 + (b) * 16 + q * 4); \
        dst[q * 4] = t4.x; dst[q * 4 + 1] = t4.y; dst[q * 4 + 2] = t4.z; dst[q * 4 + 3] = t4.w; } } while (0)
__device__ __forceinline__ void peer_sliced8(Frame& F) {
    GAS const char* H2 = (GAS const char*)(F.ws + WS_C); GAS const char* UT = (GAS const char*)(F.ws + WS_U8); GAS const char* VT = (GAS const char*)(F.ws + WS_V8);
    GAS const int* EID = (GAS const int*)(F.ws + WS_EID);
    GAS char* PO = (GAS char*)(F.ws + WS_A);
    GAS const float* MOD = (GAS const float*)(F.ws + WS_MOD); GAS const float* fw = F.inp(29);
    GAS float* X = F.out; GAS const float* XIN = F.inp(0); GAS const bf16* D1 = (GAS const bf16*)(F.ws + WS_D);
    const int lane = F.lane, g = lane >> 3, c = lane & 7;
    LAS int* EIDT = (LAS int*)(F.lds + F.wave * 13824);
    LAS float* ACTT = (LAS float*)(F.lds + F.wave * 13824 + 4608);
    LAS float* W2T = (LAS float*)(F.lds + F.wave * 13824 + 9216);
    LAS float* G2L = (LAS float*)(F.lds + 8 * 13824);
    LAS float* RSL = (LAS float*)(F.lds + 8 * 13824 + 8192) + F.wave * 8;
    for (int arep = 0; arep < 1 + PEER_REP_ALL; ++arep)
    for (int grp = F.vcu; grp < M / 64; grp += F.G) {
        const int tok0 = grp * 64 + F.wave * 8;
        { GAS const float* g2b = MOD + (size_t)((grp * 64) >> 12) * NMOD + 5 * D; *(LAS f32x4*)(G2L + F.tid * 4) = *(GAS const f32x4*)(g2b + F.tid * 4); }
        __syncthreads();
#pragma unroll
        for (int tt = 0; tt < 8; ++tt) { const unsigned eo = (unsigned)(tok0 + tt) * 128u + (unsigned)lane; EIDT[tt * 132 + lane] = EID[eo]; EIDT[tt * 132 + 64 + lane] = EID[eo + 64u]; }
        LDS_WAIT(); asm volatile("" ::: "memory");
        const unsigned c16 = (unsigned)c * 16u;
        for (int urep = 0; urep < 1 + PEER_REP_U; ++urep) {
            int acc[16];
#pragma unroll
            for (int k = 0; k < 16; ++k) acc[k] = 0;
            v4u rA[16], rB[16]; int ids[16];
            float su[16], sg[16], sv[16];
            const float hsc = ((GAS const float*)(F.ws + WS_HSC))[tok0 + g];
            { GAS const float* GWs = (GAS const float*)(F.ws + WS_GW); GAS const float* USCs = (GAS const float*)(F.ws + WS_USC); GAS const float* VSCs = (GAS const float*)(F.ws + WS_VSC);
              const unsigned go = (unsigned)(tok0 + g) * 128u + (unsigned)c;
#pragma unroll
              for (int k = 0; k < 16; ++k) { const unsigned e = (unsigned)EIDT[g * 132 + 8 * k + c]; su[k] = USCs[e]; sv[k] = VSCs[e]; sg[k] = GWs[go + 8u * k]; } }
            P8_LOAD_IDS(ids, 0); P8_ISSUE(rA, UT, c16, ids);
#pragma unroll
            for (int k = 0; k < 16; ++k) { ACTT[g * 132 + 8 * k + c] = su[k]; W2T[g * 132 + 8 * k + c] = sg[k] * sv[k]; }
            GAS const char* H8 = (GAS const char*)(F.ws + WS_H8);
#pragma unroll 1
            for (int s = 0; s < P8_NS; ++s) {
                if (SLICE_SYNC) __builtin_amdgcn_s_barrier();
                const v4u hq = *(GAS const v4u*)(H8 + ((unsigned)(tok0 + g) * D + (unsigned)s * 128u + c16));
                const int h0 = (int)hq.x, h1 = (int)hq.y, h2_ = (int)hq.z, h3 = (int)hq.w;
                const unsigned ubs = c16 + ((unsigned)s << 21), ubn = c16 + ((unsigned)(s + 1 < P8_NS ? s + 1 : s) << 21);
#define P8_U_STEP(b, cur, nxt) do { \
                    P8_LOAD_IDS(ids, ((b) + 1) & 7); P8_ISSUE(nxt, UT, ((b) == 7 ? ubn : ubs), ids); \
                    asm volatile("" ::: "memory"); \
                    _Pragma("unroll") for (int i = 0; i < 16; ++i) { const int w0 = (int)cur[i].x, w1 = (int)cur[i].y, w2 = (int)cur[i].z, w3 = (int)cur[i].w; \
                        int p = __builtin_amdgcn_sdot4(w0, h0, 0, false); p = __builtin_amdgcn_sdot4(w1, h1, p, false); p = __builtin_amdgcn_sdot4(w2, h2_, p, false); p = __builtin_amdgcn_sdot4(w3, h3, p, false); \
                        p += __builtin_amdgcn_update_dpp(0, p, 0xB1, 0xf, 0xf, false); p += __builtin_amdgcn_update_dpp(0, p, 0x4E, 0xf, 0xf, false); p += __builtin_amdgcn_update_dpp(0, p, 0x141, 0xf, 0xf, false); \
                        acc[(b) * 2 + (i >> 3)] += (c == (i & 7)) ? p : 0; } \
                    asm volatile("" ::: "memory"); } while (0)
                P8_U_STEP(0, rA, rB); P8_U_STEP(1, rB, rA); P8_U_STEP(2, rA, rB); P8_U_STEP(3, rB, rA);
                P8_U_STEP(4, rA, rB); P8_U_STEP(5, rB, rA); P8_U_STEP(6, rA, rB); P8_U_STEP(7, rB, rA);
#undef P8_U_STEP
            }
#pragma unroll
            for (int k = 0; k < 16; ++k) { const int i = g * 132 + 8 * k + c;
                ACTT[i] = gelu_tanh((float)acc[k] * (ACTT[i] * hsc)) * W2T[i]; }
        }
        LDS_WAIT(); asm volatile("" ::: "memory");
        for (int vrep = 0; vrep < 1 + PEER_REP_V; ++vrep) {
            v4u rA[16], rB[16]; int ids[16]; float av[16];
            P8_LOAD_IDS(ids, 0); P8_ISSUE(rA, VT, c16, ids);
            const unsigned xro = (unsigned)(tok0 + g) * (D * 2) + (unsigned)c * 32u;
            v4u xn0 = *(GAS const v4u*)((GAS const char*)D1 + xro), xn1 = *(GAS const v4u*)((GAS const char*)D1 + xro + 16u);
            float ssq = 0.f;
#pragma unroll 1
            for (int s = 0; s < P8_NS; ++s) {
                if (SLICE_SYNC) __builtin_amdgcn_s_barrier();
                const v4u xc0 = xn0, xc1 = xn1;
                { const unsigned xo2 = xro + (unsigned)(s + 1 < P8_NS ? s + 1 : s) * 256u; xn0 = *(GAS const v4u*)((GAS const char*)D1 + xo2); xn1 = *(GAS const v4u*)((GAS const char*)D1 + xo2 + 16u); }
                const unsigned vbs = c16 + ((unsigned)s << 21), vbn = c16 + ((unsigned)(s + 1 < P8_NS ? s + 1 : s) << 21);
                f32x2 o[8];
#pragma unroll
                for (int k = 0; k < 8; ++k) o[k] = (f32x2){0.f, 0.f};
#define P8_V_STEP(b, cur, nxt) do { \
                    P8_LOAD_IDS(ids, ((b) + 1) & 7); P8_ISSUE(nxt, VT, ((b) == 7 ? vbn : vbs), ids); \
                    _Pragma("unroll") for (int q = 0; q < 4; ++q) { const f32x4 a4 = *(const LAS f32x4*)(ACTT + g * 132 + (b) * 16 + q * 4); av[q * 4] = a4.x; av[q * 4 + 1] = a4.y; av[q * 4 + 2] = a4.z; av[q * 4 + 3] = a4.w; } \
                    asm volatile("" ::: "memory"); \
                    _Pragma("unroll") for (int i = 0; i < 16; ++i) { const unsigned w0 = cur[i].x, w1 = cur[i].y, w2 = cur[i].z, w3 = cur[i].w; const f32x2 a2 = (f32x2){av[i], av[i]}; \
                        o[0] += a2 * __builtin_amdgcn_cvt_pk_f32_fp8((int)w0, false); o[1] += a2 * __builtin_amdgcn_cvt_pk_f32_fp8((int)w0, true); \
                        o[2] += a2 * __builtin_amdgcn_cvt_pk_f32_fp8((int)w1, false); o[3] += a2 * __builtin_amdgcn_cvt_pk_f32_fp8((int)w1, true); \
                        o[4] += a2 * __builtin_amdgcn_cvt_pk_f32_fp8((int)w2, false); o[5] += a2 * __builtin_amdgcn_cvt_pk_f32_fp8((int)w2, true); \
                        o[6] += a2 * __builtin_amdgcn_cvt_pk_f32_fp8((int)w3, false); o[7] += a2 * __builtin_amdgcn_cvt_pk_f32_fp8((int)w3, true); } \
                    if (VALU_PROBE) { _Pragma("unroll") for (int i = 0; i < 16; ++i) { unsigned w0 = cur[i].x & 0x3f3f3f3fu, w1 = cur[i].y & 0x3f3f3f3fu, w2 = cur[i].z & 0x3f3f3f3fu, w3 = cur[i].w & 0x3f3f3f3fu; asm volatile("" : "+v"(w0), "+v"(w1), "+v"(w2), "+v"(w3)); const f32x2 a2 = (f32x2){av[i] * 0.f, av[i] * 0.f}; \
                        o[0] += a2 * __builtin_amdgcn_cvt_pk_f32_fp8((int)w0, false); o[1] += a2 * __builtin_amdgcn_cvt_pk_f32_fp8((int)w0, true); \
                        o[2] += a2 * __builtin_amdgcn_cvt_pk_f32_fp8((int)w1, false); o[3] += a2 * __builtin_amdgcn_cvt_pk_f32_fp8((int)w1, true); \
                        o[4] += a2 * __builtin_amdgcn_cvt_pk_f32_fp8((int)w2, false); o[5] += a2 * __builtin_amdgcn_cvt_pk_f32_fp8((int)w2, true); \
                        o[6] += a2 * __builtin_amdgcn_cvt_pk_f32_fp8((int)w3, false); o[7] += a2 * __builtin_amdgcn_cvt_pk_f32_fp8((int)w3, true); } } \
                    asm volatile("" ::: "memory"); } while (0)
                P8_V_STEP(0, rA, rB); P8_V_STEP(1, rB, rA); P8_V_STEP(2, rA, rB); P8_V_STEP(3, rB, rA);
                P8_V_STEP(4, rA, rB); P8_V_STEP(5, rB, rA); P8_V_STEP(6, rA, rB); P8_V_STEP(7, rB, rA);
#undef P8_V_STEP
                {   const LAS f32x4* gp = (const LAS f32x4*)(G2L + s * 128 + c * 16);
                    const f32x4 ga = gp[0], gb = gp[1], gc = gp[2], gd = gp[3];
                    o[0] = (f32x2){bflo(xc0.x), bfhi(xc0.x)} + (f32x2){ga.x, ga.y} * o[0]; o[1] = (f32x2){bflo(xc0.y), bfhi(xc0.y)} + (f32x2){ga.z, ga.w} * o[1];
                    o[2] = (f32x2){bflo(xc0.z), bfhi(xc0.z)} + (f32x2){gb.x, gb.y} * o[2]; o[3] = (f32x2){bflo(xc0.w), bfhi(xc0.w)} + (f32x2){gb.z, gb.w} * o[3];
                    o[4] = (f32x2){bflo(xc1.x), bfhi(xc1.x)} + (f32x2){gc.x, gc.y} * o[4]; o[5] = (f32x2){bflo(xc1.y), bfhi(xc1.y)} + (f32x2){gc.z, gc.w} * o[5];
                    o[6] = (f32x2){bflo(xc1.z), bfhi(xc1.z)} + (f32x2){gd.x, gd.y} * o[6]; o[7] = (f32x2){bflo(xc1.w), bfhi(xc1.w)} + (f32x2){gd.z, gd.w} * o[7];
#pragma unroll
                    for (int k = 0; k < 8; ++k) ssq += o[k].x * o[k].x + o[k].y * o[k].y; }
                v4u w0, w1; w0.x = pk2(o[0].x, o[0].y); w0.y = pk2(o[1].x, o[1].y); w0.z = pk2(o[2].x, o[2].y); w0.w = pk2(o[3].x, o[3].y);
                w1.x = pk2(o[4].x, o[4].y); w1.y = pk2(o[5].x, o[5].y); w1.z = pk2(o[6].x, o[6].y); w1.w = pk2(o[7].x, o[7].y);
                const unsigned po = (unsigned)(tok0 + g) * (D * 2) + (unsigned)s * 256u + (unsigned)c * 32u;
                *(GAS v4u*)(PO + po) = w0; *(GAS v4u*)(PO + po + 16u) = w1;
            }
            DPP_ADDF(ssq, 0xB1); DPP_ADDF(ssq, 0x4E); DPP_ADDF(ssq, 0x141);
            if (c == 0) RSL[g] = 1.0f / sqrtf(ssq * (1.0f / D) + EPS);
        }
        GAS float* Xo = (arep < PEER_REP_ALL) ? (GAS float*)(F.ws + WS_A + 64 * MiB) : X;
        VM_WAIT();
        LDS_WAIT(); asm volatile("" ::: "memory");
        static_assert(XR_EPI == 1 && DIAG == 0, "the in-sweep residual form reads the bf16 residual stream and has no DIAG hooks");
        f32x4 fwv[4][2];
#pragma unroll
        for (int j = 0; j < 4; ++j) { fwv[j][0] = *(GAS const f32x4*)(fw + j * 512 + lane * 8); fwv[j][1] = *(GAS const f32x4*)(fw + j * 512 + lane * 8 + 4); }
#pragma unroll 1
        for (int tt = 0; tt < 8; tt += 4) {
            v4u xw[4][4]; float rs[4];
#pragma unroll
            for (int q = 0; q < 4; ++q) { rs[q] = RSL[tt + q];
#pragma unroll
                for (int j = 0; j < 4; ++j) xw[q][j] = *(GAS const v4u*)(PO + ((size_t)(tok0 + tt + q) * D + j * 512 + lane * 8) * 2); }
#pragma unroll
            for (int q = 0; q < 4; ++q) { const int tok = tok0 + tt + q;
#pragma unroll
                for (int j = 0; j < 4; ++j) { const int col = j * 512 + lane * 8; const v4u p = xw[q][j];
                    const f32x4 wa = fwv[j][0] * rs[q], wb = fwv[j][1] * rs[q];
                    *(GAS f32x4*)(Xo + (size_t)tok * D + col) = (f32x4){bflo(p.x) * wa.x, bfhi(p.x) * wa.y, bflo(p.y) * wa.z, bfhi(p.y) * wa.w};
                    *(GAS f32x4*)(Xo + (size_t)tok * D + col + 4) = (f32x4){bflo(p.z) * wb.x, bfhi(p.z) * wb.y, bflo(p.w) * wb.z, bfhi(p.w) * wb.w}; } }
        }
        LDS_WAIT(); asm volatile("" ::: "memory");
    }
}


__device__ __forceinline__ void diag8_hc(Frame& F) {
    GAS const float* MOD = (GAS const float*)(F.ws + WS_MOD) + (size_t)4 * NMOD; GAS float* HC = (GAS float*)(F.ws + WS_I);
    for (int r = F.gw; r < MC; r += F.NGW) {
        GAS const float* xr = F.inp(2) + (size_t)r * D; float v[32]; float ss = 0.f;
#pragma unroll
        for (int i = 0; i < 32; ++i) { v[i] = xr[i * 64 + F.lane]; ss += v[i] * v[i]; }
        const float rstd = 1.0f / sqrtf(wave_sum(ss) * (1.0f / D) + EPS);
#pragma unroll
        for (int i = 0; i < 32; ++i) { const int col = i * 64 + F.lane; HC[(size_t)r * D + col] = v[i] * rstd * F.inp(6)[col] * (1.0f + MOD[D + col]) + MOD[col]; }
    }
}
__device__ __forceinline__ void diag8_check(Frame& F) {
    GAS const float* HC = (GAS const float*)(F.ws + WS_I); GAS const float* W = F.inp(8); GAS const bf16* US = (GAS const bf16*)(F.ws + WS_B);
    float num = 0.f, den = 0.f;
    for (int o = (blockIdx.x * 512 + F.tid); o < MC * 1024; o += F.G * 512) {
        const int r = o >> 10, cc = o & 1023;
        float a = 0.f;
        for (int k = 0; k < D; ++k) a += HC[(size_t)r * D + k] * W[(size_t)k * INW + cc];
        const int b = r >> 8, tp = r & 255, crow = 512 + b * NCHC + (((tp >> 5) + (DIAG == 9 ? 1 : 0)) & 7), sidx = tp & 31, g = cc >> 4, hh = cc & 15;
        const float mine = bflo((unsigned)US[((size_t)g * CROWS + crow) * USLD + sidx * 16 + hh]);
        num += (a - mine) * (a - mine); den += a * a;
    }
    num = wave_sum(num); den = wave_sum(den);
    if (F.lane == 0) { atomicAdd((float*)((unsigned*)(F.ws + WS_CTL) + CW_DNUM), num); atomicAdd((float*)((unsigned*)(F.ws + WS_CTL) + CW_DDEN), den); }
}

__global__ void __launch_bounds__(NWAVES * 64, 2) fwd_kernel(Args args) {
    extern __shared__ __attribute__((aligned(16))) unsigned char lds_raw[];
    Frame F;
    F.lds = (LAS unsigned char*)lds_raw;
    F.wave0 = __builtin_amdgcn_readfirstlane((int)threadIdx.x >> 6);
    F.G = gridDim.x; { const int bx = blockIdx.x; F.vcu = (F.G % 8 == 0) ? (bx % 8) * (F.G / 8) + bx / 8 : bx; }
    F.NGW = F.G * NWAVES;
    frame_refresh(F);
    F.out = (GAS float*)args.out; F.ws = (GAS unsigned char*)args.ws;
    unsigned char* ws0 = args.ws;
    volatile LAS unsigned* MISC = (volatile LAS unsigned*)(F.lds + MISC_OFF);
    if (F.tid < 64) MISC[F.tid] = 0u;
    if (F.tid < 30) ((LAS unsigned long long*)(F.lds + TAB_OFF))[F.tid] = (unsigned long long)args.in[F.tid];
    __syncthreads();
#if MK_ONE_LAUNCH
    (void)xcd_barrier_post((unsigned*)(ws0 + WS_CTL) + CW_BAR, MISC + 8);
#endif
    const int lo = args.ph_lo, hi = args.ph_hi;
    constexpr int REPK = REP_PHASE;
    const int nsteps = (hi - lo) + ((REPK >= lo && REPK < hi) ? 1 : 0);
    for (int step = 0; step < nsteps; ++step) {
        const int ph = lo + ((REPK >= 0 && step > REPK - lo) ? step - 1 : step);
        unsigned long long wsu = (unsigned long long)args.ws, outu = (unsigned long long)args.out; int Gv = gridDim.x, bx = blockIdx.x;
        asm volatile("" : "+s"(wsu), "+s"(outu), "+s"(Gv), "+s"(bx));
        GAS unsigned char* ws = (GAS unsigned char*)wsu;
        F.ws = ws; F.out = (GAS float*)outu; F.G = Gv; F.vcu = (Gv % 8 == 0) ? (bx % 8) * (Gv / 8) + bx / 8 : bx; F.NGW = Gv * NWAVES;
        switch (ph) {

        case 0: { frame_refresh(F);
            if (F.G == 256) {
                if (bx < 128) { s5_tables(F, bx >> 1, (bx & 1) * 2, 4, 1, 1, 2); frame_refresh(F); }
                else { mod_full(F, bx - 128); weight_transposes(F, (bx - 128) * NWAVES + F.wave, 128 * NWAVES);
                       if (PEER_FP8) convert_table_q8_dyn<true>(F, F.inp(27), ws + WS_U8, (GAS float*)(ws + WS_USC), (unsigned*)(ws + WS_CTL) + CW_UCNT); }
            } else { for (int g = bx; g < 64; g += F.G) s5_tables(F, g, 0, 1); mod_partials(F, bx, F.G); win_amax_partials(F, F.inp(8), INW, (GAS float*)(ws + WS_WAM), bx * NWAVES + F.wave, F.G * NWAVES); if (Q_I8) win_amax_partials(F, F.inp(24), D, (GAS float*)(ws + WS_WAMQ), bx * NWAVES + F.wave, F.G * NWAVES); weight_transposes(F, bx * NWAVES + F.wave, F.G * NWAVES); }
        } break;
        case 1: { frame_refresh(F); if (Gv == 256) break;
            p1_convert(F); win_transpose_q8(F, F.inp(8), INW, (GAS const float*)(ws + WS_WAM), ws + WS_WIN, (GAS float*)(ws + WS_WSC), F.gw, F.NGW);
            if (Q_I8) win_transpose_q8(F, F.inp(24), D, (GAS const float*)(ws + WS_WAMQ), ws + WS_WQ, (GAS float*)(ws + WS_WQSC), F.gw, F.NGW); } break;
        case 2: { frame_refresh(F);
            GAS const float* MOD = (GAS const float*)(ws + WS_MOD); GAS bf16* XN = (GAS bf16*)(ws + WS_C);
            if (Gv == 256) {
                if (bx < INW / 32) win_quant_strip(F, F.inp(8), INW, ws + WS_WIN, (GAS float*)(ws + WS_WSC), bx);
                else if (Q_I8) win_quant_strip(F, F.inp(24), D, ws + WS_WQ, (GAS float*)(ws + WS_WQSC), bx - INW / 32);
                frame_refresh(F);
                for (int e = F.gw * 64 + F.lane; e < 2 * 16384; e += F.NGW * 64) { const float v = e < 16384 ? F.inp(25)[e] : F.inp(26)[e - 16384]; ((GAS bf16*)(ws + WS_K12))[e] = (bf16)f2bf(v); }
                frame_refresh(F);
            }
            if (Gv == 256 && MOD_HANDOFF) {
                if (F.wave == 0) { GAS unsigned* rdy = (GAS unsigned*)(ws + WS_CTL) + CW_MODRDY; unsigned sp = 0;
                    while ((unsigned)__builtin_amdgcn_readfirstlane((int)__hip_atomic_load(rdy, __ATOMIC_RELAXED, __HIP_MEMORY_SCOPE_AGENT)) < 128u) { __builtin_amdgcn_s_sleep(1); if (++sp > (1u << 22)) break; } }
                __syncthreads();
                __builtin_amdgcn_fence(__ATOMIC_ACQUIRE, "agent"); asm volatile("s_waitcnt vmcnt(0)" ::: "memory");
                frame_refresh(F);
            }
            if (Gv == 256) {
                { const int r = F.gw * 8; GAS const float* mrow = MOD + (size_t)(r >> 12) * NMOD;
                  modnorm_group<false, false>(F.lane, 8, F.inp(0) + (size_t)r * D, F.inp(6), mrow, mrow + D, nullptr, ws + WS_C + (size_t)r * D, (GAS float*)(ws + WS_XNS) + r); }
                if (F.gw < MT - M) { const int r = M + F.gw; GAS const float* mrow = MOD + (size_t)4 * NMOD;
                    GAS const float* xr[1] = {F.inp(2) + (size_t)F.gw * D}; GAS const float* sh[1] = {mrow}; GAS const float* sc[1] = {mrow + D}; GAS bf16* orow[1] = {nullptr}; GAS const bf16* dr[1] = {nullptr}; GAS unsigned char* qd[1] = {ws + WS_C + (size_t)r * D}; GAS float* qs[1] = {(GAS float*)(ws + WS_XNS) + r};
                    modnorm_rows<true, 1, false>(F.lane, xr, dr, F.inp(6), sh, sc, orow, qd, qs); }
            } else
            for (int r0 = F.gw; r0 < MT; r0 += 2 * F.NGW) {
                GAS const float* xr[2]; GAS const float* sh[2]; GAS const float* sc[2]; GAS bf16* orow[2] = {nullptr, nullptr}; GAS const bf16* dr[2] = {nullptr, nullptr}; GAS unsigned char* qd[2]; GAS float* qs[2];
#pragma unroll
                for (int q = 0; q < 2; ++q) { int r = r0 + q * F.NGW; if (r >= MT) r = r0;
                    GAS const float* mrow;
                    if (r < M) { xr[q] = F.inp(0) + (size_t)r * D; mrow = MOD + (size_t)(r >> 12) * NMOD; } else { xr[q] = F.inp(2) + (size_t)(r - M) * D; mrow = MOD + (size_t)4 * NMOD; }
                    sh[q] = mrow; sc[q] = mrow + D; qd[q] = ws + WS_C + (size_t)r * D; qs[q] = (GAS float*)(ws + WS_XNS) + r; }
                modnorm_rows<true, 2, false>(F.lane, xr, dr, F.inp(6), sh, sc, orow, qd, qs);
            }
            if (DIAG == 8 || DIAG == 9) diag8_hc(F);
        } break;
        case 3: { frame_refresh(F);
            SchedZ S{(GAS const char*)(ws + WS_C), (GAS const char*)(ws + WS_WIN), F.G, bx};
            EpiZ E{(GAS bf16*)(ws + WS_B), (GAS bf16*)(ws + WS_G), (GAS bf16*)(ws + WS_A), (GAS const float*)(ws + WS_XNS), (GAS const float*)(ws + WS_WSC)};
            pg8::gemm_phase<PG8_ALIGN_DEFAULT, PG8_SP2_DEFAULT, true>(F.tid, F.lds, S, E, D / 2, D / 2, D / 2);
            if (PEER_FP8) {
                frame_refresh(F);
                const bool split = (F.G == 256); const int nconv = split ? F.G - 16 : F.G, cidx = split ? bx - 16 : bx;
                if (cidx >= 0) { if (!split) convert_table_q8<true>(F, F.inp(27), ws + WS_U8, (GAS float*)(ws + WS_USC), cidx * NWAVES + F.wave, nconv * NWAVES);
                                 convert_table_q8<false>(F, F.inp(28), ws + WS_V8, (GAS float*)(ws + WS_VSC), cidx * NWAVES + F.wave, nconv * NWAVES); }
            }
        } break;
        case 4: { frame_refresh(F);
            if (DIAG == 8 || DIAG == 9) { diag8_check(F); frame_refresh(F); }
            if (Gv == 256 && F.vcu >= 192) pool_prep4(F, F.vcu - 192, 64, 8, 0, 512);
            else {
            SchedS5a S{(GAS const char*)(ws + WS_B), (GAS const char*)(ws + WS_E), F.G, F.vcu};
            EpiHloc E{(GAS bf16*)(ws + WS_F)};
            pg8::gemm_phase(F.tid, F.lds, S, E, 512, USLD, 512);
            }
        } break;
        case 5: { frame_refresh(F);
            if (DIAG == 7 || DIAG == 10 || DIAG == 11) s5_naive(F);
            if (F.G == 256) { s5_scan4(F, bx); frame_refresh(F); pool_prep4(F, bx, 256, 2, 512, 1024); }
            else if (F.G >= 128) { if (bx < 64) s5_scan(F, bx); else pool_prep(F, bx - 64, F.G - 64); }
            else { for (int q = bx; q < 64; q += F.G) s5_scan(F, q); pool_prep(F, bx, F.G); }
        } break;
        case 6: { frame_refresh(F);
            if (DIAG == 7) {
                GAS const float* YN = (GAS const float*)(ws + WS_YN); GAS const bf16* US = (GAS const bf16*)(ws + WS_B); GAS bf16* G1 = (GAS bf16*)(ws + WS_C + 32 * MiB); GAS const float* dsk = F.inp(16);
                for (size_t e = (size_t)F.gw * 64 + F.lane; e < (size_t)M * S5W; e += (size_t)F.NGW * 64) {
                    const int tok = (int)(e >> 10), c = (int)(e & 1023), g = c >> 4, h = c & 15, b = tok >> 12, tp = tok & 4095;
                    const float uval = bflo((unsigned)US[((size_t)g * CROWS + b * NCHL + (tp >> 5)) * USLD + (tp & 31) * 16 + h]);
                    G1[e] = (bf16)f2bf(gelu_tanh(YN[e] + dsk[c] * uval));
                }
                break;
            }
            { SchedS5c S{(GAS const char*)(ws + WS_B), (GAS const char*)(ws + WS_D), F.G, F.vcu};
              EpiS5c E{(GAS const bf16*)(ws + WS_B), (GAS bf16*)(ws + WS_C + 32 * MiB), F.inp(16), (DIAG == 10 || DIAG == 11) ? (GAS const float*)F.out : (GAS const float*)(ws + WS_END), (unsigned*)(ws + WS_CTL)};
              pg8::gemm_phase(F.tid, F.lds, S, E, 768, USLD, 768); }
        } break;
        case 7: { frame_refresh(F);
            { SchedPool S{(GAS const char*)(ws + WS_C), (GAS const char*)(ws + WS_WPOOL), F.G, F.vcu};
              EpiPool E{(GAS bf16*)(ws + WS_I), F.inp(20)};
              pg8::gemm_phase(F.tid, F.lds, S, E, 256, 1024, 256); }
        } break;
        case 8: { frame_refresh(F);
            SchedStd S{(GAS const char*)(ws + WS_C + 32 * MiB), (GAS const char*)(ws + WS_WGLU), 64, 4, F.G, bx, (size_t)256 * 1024 * 2, (size_t)256 * 1024 * 2};
            EpiGlu E{(GAS const bf16*)(ws + WS_C + 32 * MiB), (GAS bf16*)(ws + WS_G), F.inp(18)};
            pg8::gemm_phase(F.tid, F.lds, S, E, 1024, 1024, 1024);
            if (Gv == 256 && MERGE_CHAIN) {
                asm volatile("s_waitcnt vmcnt(0)" ::: "memory"); __syncthreads();
                if (F.tid == 0) { int pm, pn; pg8::std_order(bx, 64, 4, pm, pn);
                    __hip_atomic_fetch_add((unsigned*)(ws + WS_CTL) + CW_GLURDY + pm * 32, 1u, __ATOMIC_RELAXED, __HIP_MEMORY_SCOPE_AGENT); }
            }
        } break;
        case 9: { frame_refresh(F);
            SchedMerge S{(GAS const char*)(ws + WS_G), (GAS const char*)(ws + WS_I), (GAS const char*)(ws + WS_PROJA), (GAS const char*)(ws + WS_PROJB), F.G, bx, (GAS unsigned*)(ws + WS_CTL) + CW_GLURDY};
            EpiMerge2 E{(GAS const bf16*)(ws + WS_A), (GAS bf16*)(ws + WS_B)};
            pg8::gemm_phase(F.tid, F.lds, S, E, 1024, 1024, 1024);
            if (Gv == 256 && WOUT_CHAIN) {
                asm volatile("s_waitcnt vmcnt(0)" ::: "memory"); __syncthreads();
                if (F.tid == 0) for (int t = 0; t < 2; ++t) { int pm, pn; pg8::std_order(bx + t * 256, 64, 8, pm, pn); __hip_atomic_fetch_add((unsigned*)(ws + WS_CTL) + CW_MMRDY + pm * 32, 1u, __ATOMIC_RELAXED, __HIP_MEMORY_SCOPE_AGENT); }
            }
        } break;
        case 10: break;
        case 11: { frame_refresh(F);
            SchedWout S{(GAS const char*)(ws + WS_B), (GAS const char*)(ws + WS_WOUT), 64, 8, F.G, bx, (size_t)256 * D * 2, (size_t)256 * D * 2, (Gv == 256 && WOUT_CHAIN) ? (GAS unsigned*)(ws + WS_CTL) + CW_MMRDY : (GAS unsigned*)nullptr};
            EpiWout E{(GAS bf16*)(ws + WS_D), (GAS const float*)(ws + WS_MOD), F.inp(0)};
            pg8::gemm_phase(F.tid, F.lds, S, E, D, D, D);
        } break;
        case 12: { frame_refresh(F);
            GAS const float* MOD = (GAS const float*)(ws + WS_MOD); GAS bf16* H2 = (GAS bf16*)(ws + WS_C);
            if (Gv == 256 && XR_EPI && PEER_FP8) {
                const int r = F.gw * 8; GAS const float* mrow = MOD + (size_t)(r >> 12) * NMOD;
                modnorm_group<!(Q_I8 && PEER_FP8), true>(F.lane, 8, (GAS const bf16*)(ws + WS_D) + (size_t)r * D, F.inp(7), mrow + 3 * D, mrow + 4 * D, H2 + (size_t)r * D, ws + WS_H8 + (size_t)r * D, (GAS float*)(ws + WS_HSC) + r);
            } else
            for (int r0 = F.gw; r0 < M; r0 += 2 * F.NGW) {
                GAS const float* xr[2]; GAS const bf16* dr[2]; GAS const float* sh[2]; GAS const float* sc[2]; GAS bf16* orow[2]; GAS unsigned char* qd[2]; GAS float* qs[2];
#pragma unroll
                for (int q = 0; q < 2; ++q) { const int r = r0 + q * F.NGW; GAS const float* mrow = MOD + (size_t)(r >> 12) * NMOD;
                    xr[q] = F.inp(0) + (size_t)r * D; dr[q] = (GAS const bf16*)(ws + WS_D) + (size_t)r * D; sh[q] = mrow + 3 * D; sc[q] = mrow + 4 * D; orow[q] = H2 + (size_t)r * D; qd[q] = ws + WS_H8 + (size_t)r * D; qs[q] = (GAS float*)(ws + WS_HSC) + r; }
                modnorm_rows<PEER_FP8 != 0, 2, !(Q_I8 && PEER_FP8), XR_EPI ? 2 : 1>(F.lane, xr, dr, F.inp(7), sh, sc, orow, qd, qs);
            }
            if (PEER_FP8) {   }
            else { convert_table(F, F.inp(27), (GAS bf16*)(ws + WS_D), (size_t)PEER_E * D); convert_table(F, F.inp(28), (GAS bf16*)(ws + WS_B), (size_t)PEER_E * D); }
        } break;
        case 13: { frame_refresh(F);
            if (Q_I8) {
                SchedStd S{(GAS const char*)(ws + WS_H8), (GAS const char*)(ws + WS_WQ), 64, 8, F.G, bx, (size_t)256 * D, (size_t)256 * D};
                EpiQ8 E{(GAS bf16*)(ws + WS_A), (GAS const float*)(ws + WS_HSC), (GAS const float*)(ws + WS_WQSC)};
                pg8::gemm_phase<PG8_ALIGN_DEFAULT, PG8_SP2_DEFAULT, true>(F.tid, F.lds, S, E, D / 2, D / 2, D / 2);
            } else {
            SchedStd S{(GAS const char*)(ws + WS_C), (GAS const char*)(ws + WS_WQ), 64, 8, F.G, bx, (size_t)256 * D * 2, (size_t)256 * D * 2};
            EpiQ E{(GAS bf16*)(ws + WS_A)};
            pg8::gemm_phase(F.tid, F.lds, S, E, D, D, D);
            }
        } break;
        case 14: { frame_refresh(F); peer_topk(F); } break;
        case 15: { frame_refresh(F); if (PEER_FP8) peer_sliced8(F); else if (PEER_V2) peer_sliced(F); else peer_gather(F); } break;
        default: break;
        }
#if MK_ONE_LAUNCH
        if (step + 1 < nsteps && ph == 14 && Gv == 256 && PEER_FP8) { asm volatile("s_waitcnt vmcnt(0)" ::: "memory"); __syncthreads(); }
        else if (step + 1 < nsteps && ph == 0 && Gv == 256 && MOD_HANDOFF) { __syncthreads(); }
        else if (step + 1 < nsteps && ph != 6 && ph != 10 && !(ph == 1 && Gv == 256) && !(ph == 8 && Gv == 256 && MERGE_CHAIN) && !(ph == 9 && Gv == 256 && WOUT_CHAIN)) { unsigned long long bu = (unsigned long long)(ws + WS_CTL); asm volatile("" : "+s"(bu));
            XcdBarrier b2; b2.bar = (unsigned*)bu + CW_BAR; b2.x = xb_xcc_id(); b2.st = (volatile LAS unsigned*)(F.lds + MISC_OFF) + 8; frame_refresh(F); xcd_barrier(b2, F.tid);
            if (BAR_PROBE && ph == 2) { for (int q = 0; q < 4; ++q) xcd_barrier(b2, F.tid); } }
#endif
    }
}

extern "C" void kernel_launch(void* const* d_in, const int* in_sizes, int n_in, void* d_out, int out_size, void* d_ws, size_t ws_size, hipStream_t stream) {
    static int grid = 0;
    if (grid == 0) {
        if (n_in != 30 || in_sizes[0] != M * D || out_size != M * D || ws_size < WS_END + (DIAG == 7 ? 64 * MiB : 0)) {
            fprintf(stderr, "kernel_launch: unexpected shapes: n_in %d in0 %d out %d ws %zu (need %zu); nothing launched\n", n_in, n_in > 0 ? in_sizes[0] : -1, out_size, ws_size, (size_t)WS_END); grid = -1; return; }
        int dev = 0, cus = 0, per_cu = 0;
        if (hipGetDevice(&dev) != hipSuccess || hipDeviceGetAttribute(&cus, hipDeviceAttributeMultiprocessorCount, dev) != hipSuccess) { fprintf(stderr, "kernel_launch: device query failed\n"); grid = -1; return; }
        if (hipFuncSetAttribute((const void*)fwd_kernel, hipFuncAttributeMaxDynamicSharedMemorySize, LDS_BYTES) != hipSuccess) { fprintf(stderr, "kernel_launch: hipFuncSetAttribute failed\n"); grid = -1; return; }
        if (hipOccupancyMaxActiveBlocksPerMultiprocessor(&per_cu, (const void*)fwd_kernel, NWAVES * 64, LDS_BYTES) != hipSuccess || per_cu < 1) {
            fprintf(stderr, "kernel_launch: occupancy query reports %d workgroups per CU\n", per_cu); }
        (void)hipGetLastError();
        grid = cus;
    }
    if (grid < 0) return;
    if (hipMemsetAsync((char*)d_ws + WS_CTL, 0, CTL_ZERO_BYTES, stream) != hipSuccess) { fprintf(stderr, "kernel_launch: memset failed\n"); return; }
    Args a{};
    for (int i = 0; i < 30; ++i) a.in[i] = (const float*)d_in[i];
    a.out = (float*)d_out; a.ws = (unsigned char*)d_ws;
#if MK_ONE_LAUNCH
    a.ph_lo = 0; a.ph_hi = NPHASES;
    hipLaunchKernelGGL(fwd_kernel, dim3(grid), dim3(NWAVES * 64), LDS_BYTES, stream, a);
#else
    for (int p = 0; p < NPHASES; ++p) { a.ph_lo = p; a.ph_hi = p + 1; hipLaunchKernelGGL(fwd_kernel, dim3(grid), dim3(NWAVES * 64), LDS_BYTES, stream, a); }
#endif
    const hipError_t le = hipPeekAtLastError();
    if (le != hipSuccess) fprintf(stderr, "kernel_launch: launch failed: %s\n", hipGetErrorName(le));
}
```
